# Optimizing an MI355X kernel written in HIP

```python
import jax
import jax.numpy as jnp
from jax import lax
import numpy as np

D_MODEL = 1024
BATCH = 4
SEQ = 4096
DEPTH = 4

GRID_W = 64
CTX_LEN = 256
D_MIX = D_MODEL
W_LRU = D_MIX // 4
W_POOL = D_MIX // 4
W_SGU = D_MIX // 4
W_CONV = D_MIX - W_LRU - W_POOL - W_SGU
LRU_HEADS = 4
LRU_HEAD_DIM = W_LRU // LRU_HEADS
LRU_CONV_W = 4
LRU_PAD_L = LRU_CONV_W // 2
LRU_PAD_R = LRU_CONV_W - 1 - LRU_PAD_L
LRU_C = 8.0
POOL_WINDOWS = (2, 4, 8, 16)
POOL_GROUP = W_POOL // len(POOL_WINDOWS)
SGU_CHUNK = 128
SGU_HEADS = 4
SGU_HEAD_DIM = W_SGU // SGU_HEADS
CONF_CONV_W = 31
CONF_PAD = (CONF_CONV_W - 1) // 2
D_FF = 4 * D_MODEL
D_IN = 2 * W_LRU + W_POOL + 2 * W_SGU + 2 * W_CONV
N_MOD = 6
EPS = 1e-6
POS_BASE = 10000.0

kernel_name = 'hybrid_parallel_group_flow_backbone'


def rms_norm(x, g):
    xf = x.astype(jnp.float32)
    y = xf * lax.rsqrt(jnp.mean(xf * xf, axis=-1, keepdims=True) + EPS)
    return (y * g.astype(jnp.float32)).astype(x.dtype)


def layer_norm(x, g, b):
    xf = x.astype(jnp.float32)
    mu = jnp.mean(xf, axis=-1, keepdims=True)
    xc = xf - mu
    var = jnp.mean(xc * xc, axis=-1, keepdims=True)
    y = xc * lax.rsqrt(var + EPS) * g.astype(jnp.float32) + b.astype(jnp.float32)
    return y.astype(x.dtype)


def modulate(h, shift, scale):
    return h * (1.0 + scale) + shift


def grid_pos_embed(n_tokens, dim):
    rows = n_tokens // GRID_W
    row = jnp.broadcast_to(jnp.arange(rows)[:, None], (rows, GRID_W)).reshape(-1)
    col = jnp.broadcast_to(jnp.arange(GRID_W)[None, :], (rows, GRID_W)).reshape(-1)
    quarter = dim // 4
    omega = 1.0 / (POS_BASE ** (jnp.arange(quarter, dtype=jnp.float32) / quarter))

    def enc(pos):
        ang = pos.astype(jnp.float32)[:, None] * omega[None, :]
        return jnp.concatenate([jnp.sin(ang), jnp.cos(ang)], axis=-1)

    return jnp.concatenate([enc(row), enc(col)], axis=-1)


def depthwise_conv(x, w, b, pad_l, pad_r):
    y = lax.conv_general_dilated(
        x, w[:, None, :].astype(x.dtype), window_strides=(1,), padding=[(pad_l, pad_r)],
        dimension_numbers=('NWC', 'WIO', 'NWC'), feature_group_count=x.shape[-1])
    return y + b.astype(x.dtype)


def linear_scan(a, b, h0):
    b = b.at[:, 0].add(a[:, 0] * h0)

    def comb(l, r):
        return (l[0] * r[0], r[0] * l[1] + r[1])

    _, h = lax.associative_scan(comb, (a, b), axis=1)
    return h


def rglru_dir(xc, wa, ba, wx, bx, lam, h0, reverse):
    bsz, s, _ = xc.shape
    xf = xc.astype(jnp.float32)
    xh = xf.reshape(bsz, s, LRU_HEADS, LRU_HEAD_DIM)
    r = jax.nn.sigmoid(jnp.einsum('bshi,hij->bshj', xh, wa.astype(jnp.float32)).reshape(bsz, s, W_LRU) + ba.astype(jnp.float32))
    i = jax.nn.sigmoid(jnp.einsum('bshi,hij->bshj', xh, wx.astype(jnp.float32)).reshape(bsz, s, W_LRU) + bx.astype(jnp.float32))
    log_a = -LRU_C * r * jax.nn.softplus(-lam.astype(jnp.float32))
    a = jnp.exp(log_a)
    b = jnp.sqrt(-jnp.expm1(2.0 * log_a)) * (i * xf)
    if reverse:
        h = linear_scan(a[:, ::-1], b[:, ::-1], h0)
        return h[:, ::-1]
    return linear_scan(a, b, h0)


def pool_mixer(z, w, scale):
    bsz, s, _ = z.shape
    zf = z.astype(jnp.float32)
    cs = jnp.concatenate([jnp.zeros((bsz, 1, W_POOL), jnp.float32), jnp.cumsum(zf, axis=1)], axis=1)
    t = jnp.arange(s)
    outs = []
    for gi, win in enumerate(POOL_WINDOWS):
        lo = win // 2
        hi = win - lo - 1
        start = jnp.clip(t - lo, 0, s)
        end = jnp.clip(t + hi + 1, 0, s)
        sl = slice(gi * POOL_GROUP, (gi + 1) * POOL_GROUP)
        cnt = (end - start).astype(jnp.float32)[None, :, None]
        outs.append((cs[:, end, sl] - cs[:, start, sl]) / cnt - zf[..., sl])
    p = jnp.stack(outs, axis=2)
    y = jnp.einsum('bsgi,gij->bsgj', p, w.astype(jnp.float32)).reshape(bsz, s, W_POOL)
    return (y * scale.astype(jnp.float32)).astype(z.dtype)


def spatial_gating(u, v, ln_g, ln_b, ws, bs):
    bsz, s, _ = v.shape
    n_chunks = s // SGU_CHUNK
    vn = layer_norm(v, ln_g, ln_b).reshape(bsz, n_chunks, SGU_CHUNK, SGU_HEADS, SGU_HEAD_DIM)
    z = jnp.einsum('hpq,bnqhc->bnphc', ws.astype(vn.dtype), vn) + bs.T.astype(vn.dtype)[:, :, None]
    return u * z.reshape(bsz, s, W_SGU)


def conformer_conv(val, gate, w, b, ln_g, ln_b):
    y = val * jax.nn.sigmoid(gate)
    y = depthwise_conv(y, w, b, CONF_PAD, CONF_PAD)
    y = layer_norm(y, ln_g, ln_b)
    return jax.nn.silu(y)


def mix_rest(h_lru, rest, pool_w, pool_scale, sgu_ln_g, sgu_ln_b, sgu_w, sgu_b,
             conv_d_w, conv_d_b, conv_ln_g, conv_ln_b):
    idx = [W_LRU, W_LRU + W_POOL, W_LRU + W_POOL + W_SGU, W_LRU + W_POOL + 2 * W_SGU,
           W_LRU + W_POOL + 2 * W_SGU + W_CONV]
    gate, zp, u, v, cv, cg = jnp.split(rest, idx, axis=-1)
    y_a = (h_lru * jax.nn.gelu(gate.astype(jnp.float32))).astype(rest.dtype)
    y_b = pool_mixer(zp, pool_w, pool_scale)
    y_c = spatial_gating(u, v, sgu_ln_g, sgu_ln_b, sgu_w, sgu_b)
    y_d = conformer_conv(cv, cg, conv_d_w, conv_d_b, conv_ln_g, conv_ln_b)
    return jnp.concatenate([y_a, y_b, y_c, y_d], axis=-1)


def sq_relu_mlp(h, w1, w2):
    return jnp.square(jax.nn.relu(h @ w1)) @ w2


def setup_inputs(seed: int = 0) -> dict:
    key = jax.random.key(seed)
    ks = jax.random.split(key, 32)
    f32 = jnp.float32
    L = DEPTH

    def nrm(k, shape, s):
        return jax.random.normal(k, shape, f32) * s

    u = jax.random.uniform(ks[15], (L, 2, W_LRU), f32, minval=0.9, maxval=0.999)
    a_base = u ** (1.0 / LRU_C)
    lru_lambda = jnp.log(a_base) - jnp.log1p(-a_base)
    return {
        'x': nrm(ks[0], (BATCH, SEQ, D_MODEL), 1.0),
        'c': nrm(ks[1], (BATCH, D_MODEL), 1.0),
        'ctx': nrm(ks[2], (BATCH, CTX_LEN, D_MODEL), 1.0),
        'c_ctx': nrm(ks[3], (D_MODEL,), 1.0),
        'w_mod': nrm(ks[4], (L, D_MODEL, N_MOD * D_MODEL), 0.5 * D_MODEL ** -0.5),
        'b_mod': nrm(ks[5], (L, N_MOD * D_MODEL), 0.02),
        'g_norm1': 1.0 + nrm(ks[6], (L, D_MODEL), 0.02),
        'g_norm2': 1.0 + nrm(ks[7], (L, D_MODEL), 0.02),
        'w_in': nrm(ks[8], (L, D_MODEL, D_IN), D_MODEL ** -0.5),
        'conv_a_w': nrm(ks[9], (L, LRU_CONV_W, W_LRU), LRU_CONV_W ** -0.5),
        'conv_a_b': nrm(ks[10], (L, W_LRU), 0.02),
        'lru_wa': nrm(ks[11], (L, 2, LRU_HEADS, LRU_HEAD_DIM, LRU_HEAD_DIM), LRU_HEAD_DIM ** -0.5),
        'lru_ba': nrm(ks[12], (L, 2, W_LRU), 0.02),
        'lru_wx': nrm(ks[13], (L, 2, LRU_HEADS, LRU_HEAD_DIM, LRU_HEAD_DIM), LRU_HEAD_DIM ** -0.5),
        'lru_bx': nrm(ks[14], (L, 2, W_LRU), 0.02),
        'lru_lambda': lru_lambda,
        'pool_w': nrm(ks[16], (L, len(POOL_WINDOWS), POOL_GROUP, POOL_GROUP), POOL_GROUP ** -0.5),
        'pool_scale': 1.0 + nrm(ks[17], (L, W_POOL), 0.1),
        'sgu_ln_g': 1.0 + nrm(ks[18], (L, W_SGU), 0.02),
        'sgu_ln_b': nrm(ks[19], (L, W_SGU), 0.02),
        'sgu_w': nrm(ks[20], (L, SGU_HEADS, SGU_CHUNK, SGU_CHUNK), SGU_CHUNK ** -0.5),
        'sgu_b': 1.0 + nrm(ks[21], (L, SGU_HEADS, SGU_CHUNK), 0.02),
        'conv_d_w': nrm(ks[22], (L, CONF_CONV_W, W_CONV), CONF_CONV_W ** -0.5),
        'conv_d_b': nrm(ks[23], (L, W_CONV), 0.02),
        'conv_ln_g': 1.0 + nrm(ks[24], (L, W_CONV), 0.02),
        'conv_ln_b': nrm(ks[25], (L, W_CONV), 0.02),
        'w_out': nrm(ks[26], (L, D_MIX, D_MODEL), D_MIX ** -0.5),
        'w_mlp1': nrm(ks[27], (L, D_MODEL, D_FF), D_MODEL ** -0.5),
        'w_mlp2': nrm(ks[28], (L, D_FF, D_MODEL), D_FF ** -0.5),
        'g_final': 1.0 + nrm(ks[29], (D_MODEL,), 0.02),
    }


def reference(x, c, ctx, c_ctx, w_mod, b_mod, g_norm1, g_norm2, w_in, conv_a_w, conv_a_b,
              lru_wa, lru_ba, lru_wx, lru_bx, lru_lambda, pool_w, pool_scale, sgu_ln_g, sgu_ln_b,
              sgu_w, sgu_b, conv_d_w, conv_d_b, conv_ln_g, conv_ln_b, w_out, w_mlp1, w_mlp2, g_final):
    n_lat = x.shape[1]
    x = x + grid_pos_embed(n_lat, D_MODEL).astype(x.dtype)
    xc = ctx
    for l in range(DEPTH):
        last = l == DEPTH - 1
        mod_x = jax.nn.silu(c) @ w_mod[l] + b_mod[l]
        mod_c = jax.nn.silu(c_ctx) @ w_mod[l] + b_mod[l]
        shx1, scx1, gtx1, shx2, scx2, gtx2 = jnp.split(mod_x[:, None, :], N_MOD, axis=-1)
        shc1, scc1, gtc1, shc2, scc2, gtc2 = jnp.split(mod_c, N_MOD, axis=-1)
        fwd = (lru_wa[l, 0], lru_ba[l, 0], lru_wx[l, 0], lru_bx[l, 0], lru_lambda[l, 0])
        bwd = (lru_wa[l, 1], lru_ba[l, 1], lru_wx[l, 1], lru_bx[l, 1], lru_lambda[l, 1])
        rest_params = (pool_w[l], pool_scale[l], sgu_ln_g[l], sgu_ln_b[l], sgu_w[l], sgu_b[l],
                       conv_d_w[l], conv_d_b[l], conv_ln_g[l], conv_ln_b[l])

        hc = modulate(rms_norm(xc, g_norm1[l]), shc1, scc1)
        cc = depthwise_conv(hc @ w_in[l][:, :W_LRU], conv_a_w[l], conv_a_b[l], LRU_PAD_L, LRU_PAD_R)
        h0 = jnp.zeros((xc.shape[0], W_LRU), jnp.float32)
        hcf = rglru_dir(cc, *fwd, h0, False)
        hcb = rglru_dir(cc, *bwd, h0, True)

        hx = modulate(rms_norm(x, g_norm1[l]), shx1, scx1)
        px = hx @ w_in[l]
        cx = depthwise_conv(px[..., :W_LRU], conv_a_w[l], conv_a_b[l], LRU_PAD_L, LRU_PAD_R)
        hxf = rglru_dir(cx, *fwd, hcf[:, -1], False)
        hxb = rglru_dir(cx, *bwd, hcb[:, 0], True)
        yx = mix_rest(hxf + hxb, px[..., W_LRU:], *rest_params) @ w_out[l]
        x = x + gtx1 * yx
        x = x + gtx2 * sq_relu_mlp(modulate(rms_norm(x, g_norm2[l]), shx2, scx2), w_mlp1[l], w_mlp2[l])

        if not last:
            yc = mix_rest(hcf + hcb, hc @ w_in[l][:, W_LRU:], *rest_params) @ w_out[l]
            xc = xc + gtc1 * yc
            xc = xc + gtc2 * sq_relu_mlp(modulate(rms_norm(xc, g_norm2[l]), shc2, scc2), w_mlp1[l], w_mlp2[l])
    return rms_norm(x, g_final)
```

```cpp
#include <hip/hip_runtime.h>
#include <cstdio>
#include <cstdint>


#define LAS __attribute__((address_space(3)))
typedef unsigned short bf16_t;
typedef short bf16x8 __attribute__((ext_vector_type(8)));
typedef float f32x4 __attribute__((ext_vector_type(4)));
typedef float f32x2 __attribute__((ext_vector_type(2)));
typedef unsigned u32x4 __attribute__((ext_vector_type(4)));
typedef unsigned u32x2 __attribute__((ext_vector_type(2)));

constexpr int DM = 1024, NBATCH = 4, SEQ = 4096, DEPTH = 4, CTXL = 256, DIN = 1792, DFF = 4096;
constexpr int MLAT = NBATCH * SEQ, MCTX = NBATCH * CTXL, MTOT = MLAT + MCTX;
constexpr int NMODC = 6 * DM;
constexpr float EPS = 1e-6f;
constexpr int NTILE = MTOT / 128;
constexpr int NTHREADS = 512, NWAVES = 8;
constexpr int LDS_BYTES = 155648;
constexpr int HP = DFF + 64;

constexpr size_t MiB = 1u << 20;
constexpr size_t WS_MOD = 0;
constexpr size_t WS_TAB = 92 * MiB + 320 * 1024;
constexpr size_t WS_SWIN = 768 * 1024;
constexpr size_t WS_SW1 = 1 * MiB;
constexpr size_t WS_SUM = 3 * MiB / 2;
constexpr size_t WS_SS = 5 * MiB / 2;
constexpr size_t WS_WT = 4 * MiB;
constexpr size_t WT_IN = 0, WT_OUT = (size_t)DIN * DM * 2, WT_1 = WT_OUT + (size_t)DM * DM * 2, WT_2 = WT_1 + (size_t)DFF * DM * 2, WT_LAYER = WT_2 + (size_t)DM * DFF * 2;
constexpr size_t WS_BAR = 92 * MiB + 256 * 1024;
constexpr size_t WS_LW = 91 * MiB;
constexpr size_t WS_SGW = WS_LW + 512 * 1024;
constexpr size_t WS_PW = WS_SGW + 512 * 1024;
constexpr size_t WS_X = 93 * MiB;
constexpr size_t WS_XG = 161 * MiB;
constexpr size_t WS_H = 195 * MiB;
constexpr size_t WS_PX = WS_H, WS_MIX = WS_H + 60 * MiB, WS_HS = WS_H + 96 * MiB;
constexpr size_t WS_SLAB = 334 * MiB;
constexpr size_t WS_END = 366 * MiB;
static_assert(WS_WT + 4 * WT_LAYER <= WS_LW && WS_BAR + 16384 <= WS_TAB && WS_TAB + 8 * 3 * 5 * 1024 * 4 <= WS_X, "ws map");
static_assert(WS_X + (size_t)MTOT * DM * 4 <= WS_XG && WS_XG + (size_t)MTOT * DM * 2 <= WS_H && WS_H + (size_t)MTOT * HP * 2 <= WS_SLAB, "ws map");
static_assert((size_t)MTOT * DIN * 2 <= 60 * MiB && (size_t)MTOT * DM * 2 <= 36 * MiB && WS_HS + (size_t)2 * MTOT * 256 * 4 <= WS_SLAB, "ws map");

__device__ __forceinline__ unsigned f2bf(float f) { unsigned u = __builtin_bit_cast(unsigned, f); return (u + 0x7fffu + ((u >> 16) & 1u)) >> 16; }
__device__ __forceinline__ unsigned pk2(float lo, float hi) { return f2bf(lo) | (f2bf(hi) << 16); }
__device__ __forceinline__ float bf2f(unsigned b) { return __builtin_bit_cast(float, b << 16); }
__device__ __forceinline__ float wave_sum(float v) {
#pragma unroll
    for (int o = 1; o < 64; o <<= 1) v += __shfl_xor(v, o);
    return v;
}
__device__ __forceinline__ float sigmoidf_(float x) { return 1.0f / (1.0f + __expf(-x)); }
__device__ __forceinline__ float gelu_tanh(float x) {
    const float u = 0.7978845608028654f * (x + 0.044715f * x * x * x);
    const float t = 1.0f - 2.0f / (__expf(2.0f * u) + 1.0f);
    return 0.5f * x * (1.0f + t);
}

__device__ __forceinline__ float sum8sq(const float (&d)[8]) { return (d[0] * d[0] + d[1] * d[1]) + (d[2] * d[2] + d[3] * d[3]) + (d[4] * d[4] + d[5] * d[5]) + (d[6] * d[6] + d[7] * d[7]); }
__device__ __forceinline__ void unpack8(const u32x4 v, float (&f)[8]) {
    f[0] = bf2f(v.x & 0xffffu); f[1] = __builtin_bit_cast(float, v.x & 0xffff0000u); f[2] = bf2f(v.y & 0xffffu); f[3] = __builtin_bit_cast(float, v.y & 0xffff0000u);
    f[4] = bf2f(v.z & 0xffffu); f[5] = __builtin_bit_cast(float, v.z & 0xffff0000u); f[6] = bf2f(v.w & 0xffffu); f[7] = __builtin_bit_cast(float, v.w & 0xffff0000u);
}
__device__ __forceinline__ u32x4 pack8(const float (&f)[8]) { u32x4 o; o.x = pk2(f[0], f[1]); o.y = pk2(f[2], f[3]); o.z = pk2(f[4], f[5]); o.w = pk2(f[6], f[7]); return o; }
__host__ __device__ __forceinline__ unsigned hl_off(unsigned r, unsigned c) { const unsigned st = (r >> 4) * 2u + (c >> 5), ob = (r & 15u) * 64u + (c & 31u) * 2u; return (st * 1024u + (ob ^ (((ob >> 9) & 1u) << 5))) >> 1; }
__host__ __device__ __forceinline__ unsigned img_off(unsigned row, unsigned col, unsigned KT) { return (((row >> 8) * KT + (col >> 6)) << 14) + (((row >> 7) & 1u) << 13) + hl_off(row & 127u, col & 63u); }
__host__ __device__ __forceinline__ unsigned wrow_img(unsigned n) { const unsigned p = n & 31u, rho = 16u * ((p >> 2) & 1u) + 4u * (p >> 3) + (p & 3u); return (n & ~31u) | rho; }
__device__ __forceinline__ float gain_clamp(float g) { return fabsf(g) < 1e-5f ? copysignf(1e-5f, g) : g; }
__device__ __forceinline__ int opaque_tid() { int t = threadIdx.x; asm volatile("" : "+v"(t)); return t; }

struct Args { const float* in[30]; float* out; unsigned char* ws; int lo, hi; };

namespace pg8 {
constexpr int BM = 256, BK = 64, HALF = 128, HTB = HALF * BK * 2, STAGE_BYTES = 8 * HTB, NXCD = 8, WGM = 8;
__host__ __device__ __forceinline__ int lds_byte(int r, int c) { const int st = (r >> 4) * 2 + (c >> 5), rr = r & 15, cc = c & 31, ob = rr * 64 + cc * 2; return st * 1024 + (ob ^ (((ob >> 9) & 1) << 5)); }
__host__ __device__ __forceinline__ void stage_rc(int b, int& R, int& C) { const int st = b / 1024, sb = b % 1024, swz = sb ^ (((sb >> 9) & 1) << 5); R = (st >> 1) * 16 + swz / 64; C = (st & 1) * 32 + (swz % 64) / 2; }
__host__ __device__ __forceinline__ int perm32(int rho) { const int n = rho >> 4, i = rho & 15; return 8 * (i >> 2) + 4 * n + (i & 3); }

struct Unit { int pm, pn, k0, nt, S, ks, slot; };
struct Gemm { const bf16_t* A; const bf16_t* Bt; int K, lda, ldb; float* slab; size_t kstepA, tstepA; };

struct Order {
    int nM, nN, nwg, G, c, nExtra, xpm0, KT, xS;
    __device__ void init(int nM_, int nN_, int G_, int c_, int nExtra_, int xpm0_, int KT_, int xS_) { nM = nM_; nN = nN_; nwg = nM * nN; G = G_; c = c_; nExtra = nExtra_; xpm0 = xpm0_; KT = KT_; xS = xS_; }
    __device__ bool next(int i, Unit& u) const {
        long L = (long)i * G + c;
        u.k0 = 0; u.nt = KT; u.S = 0; u.ks = 0; u.slot = 0;
        if (L < nwg) {
            int wgid = (int)L; { const int q = nwg / NXCD, r = nwg % NXCD, xcd = wgid % NXCD, off = wgid / NXCD; wgid = (xcd < r ? xcd * (q + 1) : r * (q + 1) + (xcd - r) * q) + off; }
            const int nig = WGM * nN, gid = wgid / nig, fm = gid * WGM, gsz = (nM - fm) < WGM ? (nM - fm) : WGM;
            u.pm = fm + ((wgid % nig) % gsz); u.pn = (wgid % nig) / gsz; return true;
        }
        L -= nwg;
        if (L >= nExtra) return false;
        if (xS == 0) { u.pm = xpm0 + (int)L; u.pn = 0; return true; }
        const int unit = (int)L / xS, ks = (int)L % xS;
        u.pm = xpm0 + unit / nN; u.pn = unit % nN; u.S = xS; u.ks = ks; u.slot = unit; u.nt = KT / xS; u.k0 = ks * (KT / xS) * BK;
        return true;
    }
};

__device__ __forceinline__ unsigned cvt_pk_bf16(float lo, float hi) { unsigned r; asm volatile("v_cvt_pk_bf16_f32 %0, %1, %2" : "=v"(r) : "v"(lo), "v"(hi)); return r; }

__device__ __forceinline__ int row_bb(int pm) { return pm < 64 ? (pm >> 4) : 4; }

constexpr int PRE_UNITS = 6;
template <int ACT, bool TILED = false> struct EpiLin {
    bf16_t* O; int ldc; const float* ss; const float* sw; int ldsw;
    static constexpr bool PRELOAD = true;
    __device__ __forceinline__ void preload(LAS float* pre, const Order& S, int tid) const {
        f32x4 sl[PRE_UNITS][4]; float sv1[PRE_UNITS]; bool ok[PRE_UNITS];
#pragma unroll
        for (int i = 0; i < PRE_UNITS; ++i) {
            Unit u; ok[i] = S.next(i, u) && u.S == 0; if (!ok[i]) { u.pm = 0; u.pn = 0; }
            if (tid < 256) { const f32x4* sp = (const f32x4*)(ss + (size_t)(u.pm * BM + tid) * 16); sl[i][0] = sp[0]; sl[i][1] = sp[1]; sl[i][2] = sp[2]; sl[i][3] = sp[3]; }
            else sv1[i] = sw[(size_t)row_bb(u.pm) * ldsw + u.pn * BM + (tid - 256)];
        }
#pragma unroll
        for (int i = 0; i < PRE_UNITS; ++i) {
            if (tid < 256) { const f32x4 t4 = (sl[i][0] + sl[i][1]) + (sl[i][2] + sl[i][3]); pre[i * 512 + tid] = __builtin_amdgcn_rsqf(((t4[0] + t4[1]) + (t4[2] + t4[3])) * (1.0f / DM) + EPS); }
            else pre[i * 512 + tid] = sv1[i];
        }
    }
    __device__ __forceinline__ void operator()(const f32x4 (&acc)[2][2][4][2], const Unit& u, int wr, int wc, int fr, int fq, const LAS float* pre) const {
        const int col0 = u.pn * BM + wc * 32 + 8 * fq;
        f32x4 sv[2][2];
#pragma unroll
        for (int bj = 0; bj < 2; ++bj)
#pragma unroll
            for (int n = 0; n < 2; ++n) sv[bj][n] = *(const LAS f32x4*)(pre + 256 + wc * 32 + 8 * fq + bj * HALF + 4 * n);
        float rsv[2][4];
#pragma unroll
        for (int ai = 0; ai < 2; ++ai)
#pragma unroll
            for (int m = 0; m < 4; ++m) rsv[ai][m] = pre[ai * HALF + wr * 64 + m * 16 + fr];
        store(acc, u, wr, wc, fr, fq, col0, sv, rsv);
    }
    __device__ __forceinline__ void operator()(const f32x4 (&acc)[2][2][4][2], const Unit& u, int wr, int wc, int fr, int fq) const {
        const int bb = row_bb(u.pm);
        const int col0 = u.pn * BM + wc * 32 + 8 * fq;
        const float* swb = sw + (size_t)bb * ldsw + col0;
        f32x4 sv[2][2];
#pragma unroll
        for (int bj = 0; bj < 2; ++bj)
#pragma unroll
            for (int n = 0; n < 2; ++n) sv[bj][n] = *(const f32x4*)(swb + bj * HALF + 4 * n);
        f32x4 sl[2][4];
#pragma unroll
        for (int ai = 0; ai < 2; ++ai)
#pragma unroll
            for (int m = 0; m < 4; ++m) sl[ai][m] = *(const f32x4*)(ss + (size_t)(u.pm * BM + ai * HALF + wr * 64 + m * 16 + fr) * 16 + 4 * fq);
        float rsv[2][4];
#pragma unroll
        for (int ai = 0; ai < 2; ++ai)
#pragma unroll
            for (int m = 0; m < 4; ++m) { float t = (sl[ai][m][0] + sl[ai][m][1]) + (sl[ai][m][2] + sl[ai][m][3]); t += __shfl_xor(t, 16); t += __shfl_xor(t, 32); rsv[ai][m] = __builtin_amdgcn_rsqf(t * (1.0f / DM) + EPS); }
        store(acc, u, wr, wc, fr, fq, col0, sv, rsv);
    }
    __device__ __forceinline__ void store(const f32x4 (&acc)[2][2][4][2], const Unit& u, int wr, int wc, int fr, int fq, int col0, const f32x4 (&sv)[2][2], const float (&rsv)[2][4]) const {
#pragma unroll
        for (int ai = 0; ai < 2; ++ai)
#pragma unroll
            for (int m = 0; m < 4; ++m) {
                const int row = u.pm * BM + ai * HALF + wr * 64 + m * 16 + fr;
                const float rs = rsv[ai][m];
                bf16_t* rowp = TILED ? O + img_off((unsigned)row, (unsigned)col0, (unsigned)(ldc >> 6)) : O + (size_t)row * ldc + col0;
#pragma unroll
                for (int bj = 0; bj < 2; ++bj) {
                    f32x4 v0 = acc[ai][bj][m][0] * rs + sv[bj][0], v1 = acc[ai][bj][m][1] * rs + sv[bj][1];
                    if (ACT == 1) {
#pragma unroll
                        for (int e = 0; e < 4; ++e) { const float a0 = fmaxf(v0[e], 0.f), a1 = fmaxf(v1[e], 0.f); v0[e] = a0 * a0; v1[e] = a1 * a1; }
                    }
                    u32x4 w; w.x = cvt_pk_bf16(v0[0], v0[1]); w.y = cvt_pk_bf16(v0[2], v0[3]); w.z = cvt_pk_bf16(v1[0], v1[1]); w.w = cvt_pk_bf16(v1[2], v1[3]);
                    *(u32x4*)(rowp + (TILED ? bj * 2 * (256 * 64) : bj * HALF)) = w;
                }
            }
    }
};

struct EpiRes {
    bf16_t* XG; float* ss; const float* tab;
    static constexpr bool PRELOAD = false;
    __device__ __forceinline__ void operator()(const f32x4 (&acc)[2][2][4][2], const Unit& u, int wr, int wc, int fr, int fq) const {
        const int bb = row_bb(u.pm);
        const int col0 = u.pn * BM + wc * 32 + 8 * fq;
        f32x4 vr[2][2], vt[2][2], vi[2][2];
#pragma unroll
        for (int bj = 0; bj < 2; ++bj)
#pragma unroll
            for (int n = 0; n < 2; ++n) {
                const float* tp = tab + (size_t)bb * DM + col0 + bj * HALF + 4 * n;
                vr[bj][n] = *(const f32x4*)tp; vt[bj][n] = *(const f32x4*)(tp + 5 * DM); vi[bj][n] = *(const f32x4*)(tp + 10 * DM);
            }
        bf16_t* gpb = XG + img_off((unsigned)(u.pm * BM + wr * 64 + fr), (unsigned)col0, 16u);
#pragma unroll
        for (int ai = 0; ai < 2; ++ai) {
        u32x4 xin[2][4][2];
#pragma unroll
            for (int m = 0; m < 4; ++m)
#pragma unroll
                for (int bj = 0; bj < 2; ++bj) xin[ai][m][bj] = *(const u32x4*)(gpb + ai * 8192 + m * 1024 + bj * 2 * 16384);
#pragma unroll
            for (int m = 0; m < 4; ++m) {
                const int row = u.pm * BM + ai * HALF + wr * 64 + m * 16 + fr;
                bf16_t* gp = gpb + ai * 8192 + m * 1024;
                float q = 0.f;
#pragma unroll
                for (int bj = 0; bj < 2; ++bj) {
                    const u32x4 xr = xin[ai][m][bj];
                    f32x4 x0, x1;
                    x0[0] = __builtin_bit_cast(float, xr.x << 16); x0[1] = __builtin_bit_cast(float, xr.x & 0xffff0000u); x0[2] = __builtin_bit_cast(float, xr.y << 16); x0[3] = __builtin_bit_cast(float, xr.y & 0xffff0000u);
                    x1[0] = __builtin_bit_cast(float, xr.z << 16); x1[1] = __builtin_bit_cast(float, xr.z & 0xffff0000u); x1[2] = __builtin_bit_cast(float, xr.w << 16); x1[3] = __builtin_bit_cast(float, xr.w & 0xffff0000u);
                    const f32x4 y0 = x0 * vr[bj][0] + vt[bj][0] * acc[ai][bj][m][0], y1 = x1 * vr[bj][1] + vt[bj][1] * acc[ai][bj][m][1];
                    u32x4 w; w.x = cvt_pk_bf16(y0[0], y0[1]); w.y = cvt_pk_bf16(y0[2], y0[3]); w.z = cvt_pk_bf16(y1[0], y1[1]); w.w = cvt_pk_bf16(y1[2], y1[3]);
                    *(u32x4*)(gp + bj * 2 * 16384) = w;
                    const f32x4 z0 = y0 * vi[bj][0], z1 = y1 * vi[bj][1];
                    q += (z0[0] * z0[0] + z0[1] * z0[1]) + (z0[2] * z0[2] + z0[3] * z0[3]) + (z1[0] * z1[0] + z1[1] * z1[1]) + (z1[2] * z1[2] + z1[3] * z1[3]);
                }
                q += __shfl_xor(q, 16); q += __shfl_xor(q, 32);
                if (fq == 0) ss[(size_t)row * 16 + u.pn * 4 + wc] = q;
            }
        }
    }
};

template <class Epi, bool ALIGN_EPI = true>
__device__ __forceinline__ void gemm_phase(LAS unsigned char* lds, const Gemm g, const Order& S, const Epi& E) {
    const int tid = opaque_tid(), wid = __builtin_amdgcn_readfirstlane(tid >> 6), lane = tid & 63, wr = wid >> 2, wc = wid & 3, fr = lane & 15, fq = lane >> 4;
    unsigned voffA[2], voffB[2];
#pragma unroll
    for (int i = 0; i < 2; ++i) { voffA[i] = (unsigned)(tid * 16 + i * 8192); voffB[i] = voffA[i]; }
    const size_t hstepA = (size_t)HALF * g.lda * 2, hstepB = (size_t)HALF * 64 * 2;
    const size_t kstepB = (size_t)256 * 64 * 2, tstepB = (size_t)(g.K / BK) * kstepB;
    const size_t tstepA = g.tstepA, kstepA = g.kstepA;
    const unsigned ldsw = (unsigned)wid * 1024u;
    const int aoff = lds_byte(wr * 64 + fr, fq * 8), boff = lds_byte(wc * 32 + fr, fq * 8);
#define PG8_SA(b, h) (((b) * 2 + (h)) * HTB)
#define PG8_SB(b, h) ((4 + (b) * 2 + (h)) * HTB)
#define PG8_STAGE(bufoff, gbase, voff) do { _Pragma("unroll") for (int _i = 0; _i < 2; ++_i) \
        __builtin_amdgcn_global_load_lds((const unsigned*)((const char*)(gbase) + (voff)[_i]), (LAS unsigned*)(lds + (bufoff) + ldsw + _i * 8192), 16, 0, 0); } while (0)
#define PG8_LDA(dst, b, h) do { _Pragma("unroll") for (int m = 0; m < 4; ++m) _Pragma("unroll") for (int k = 0; k < 2; ++k) dst[m][k] = *(const LAS bf16x8*)(lds + PG8_SA(b, h) + aoff + m * 2048 + k * 1024); } while (0)
#define PG8_LDB(dst, b, h) do { _Pragma("unroll") for (int n = 0; n < 2; ++n) _Pragma("unroll") for (int k = 0; k < 2; ++k) dst[n][k] = *(const LAS bf16x8*)(lds + PG8_SB(b, h) + boff + n * 2048 + k * 1024); } while (0)
#define PG8_MMA(ai, bj, At, Bt) do { __builtin_amdgcn_s_setprio(1); _Pragma("unroll") for (int m = 0; m < 4; ++m) _Pragma("unroll") for (int n = 0; n < 2; ++n) _Pragma("unroll") for (int k = 0; k < 2; ++k) \
        acc[ai][bj][m][n] = __builtin_amdgcn_mfma_f32_16x16x32_bf16(Bt[n][k], At[m][k], acc[ai][bj][m][n], 0, 0, 0); __builtin_amdgcn_s_setprio(0); } while (0)
#define PG8_WAIT_V(n) asm volatile("s_waitcnt vmcnt(" #n ")" ::: "memory")
#define PG8_WAIT_L(n) asm volatile("s_waitcnt lgkmcnt(" #n ")" ::: "memory")
#define PG8_BAR __builtin_amdgcn_s_barrier()
#define PG8_SCHED __builtin_amdgcn_sched_barrier(0)
    Unit cur, nxt; int ui = 0;
    LAS float* pre = (LAS float*)(lds + STAGE_BYTES);
    if (!S.next(0, cur)) return;
    f32x4 acc[2][2][4][2];
#pragma unroll
    for (int a = 0; a < 2; ++a)
#pragma unroll
        for (int b = 0; b < 2; ++b)
#pragma unroll
            for (int m = 0; m < 4; ++m)
#pragma unroll
                for (int n = 0; n < 2; ++n) acc[a][b][m][n] = (f32x4){0.f, 0.f, 0.f, 0.f};
    bf16x8 At[4][2], B0[2][2], B1[2][2];
    const char* cA = (const char*)g.A + (size_t)cur.pm * tstepA + (size_t)(cur.k0 >> 6) * kstepA; const char* cB = (const char*)g.Bt + (size_t)cur.pn * tstepB + (size_t)(cur.k0 >> 6) * kstepB;
    PG8_STAGE(PG8_SB(0, 0), cB, voffB); PG8_STAGE(PG8_SB(0, 1), cB + hstepB, voffB); PG8_STAGE(PG8_SA(0, 0), cA, voffA); PG8_STAGE(PG8_SA(0, 1), cA + hstepA, voffA);
    if constexpr (Epi::PRELOAD) { E.preload(pre, S, tid); __syncthreads(); }
    if (wr == 1) PG8_BAR;
    PG8_WAIT_V(2); PG8_BAR;
    PG8_STAGE(PG8_SB(1, 0), cB + kstepB, voffB); PG8_STAGE(PG8_SA(1, 0), cA + kstepA, voffA); PG8_STAGE(PG8_SB(1, 1), cB + hstepB + kstepB, voffB);
    PG8_WAIT_V(6); PG8_BAR;
    for (;;) {
        const bool has_next = S.next(ui + 1, nxt);
        const char* nA = has_next ? (const char*)g.A + (size_t)nxt.pm * tstepA + (size_t)(nxt.k0 >> 6) * kstepA : cA; const char* nB = has_next ? (const char*)g.Bt + (size_t)nxt.pn * tstepB + (size_t)(nxt.k0 >> 6) * kstepB : cB;
        const int nt = cur.nt;
        for (int t = 0; t < nt; t += 2) {
            const bool last = (t == nt - 2);
            const char* a1 = cA + (size_t)(t + 1) * kstepA;
            const char* a2 = last ? nA : cA + (size_t)(t + 2) * kstepA; const char* b2 = last ? nB : cB + (size_t)(t + 2) * kstepB;
            const char* a3 = a2 + kstepA; const char* b3 = b2 + kstepB;
            PG8_LDB(B0, 0, 0); PG8_LDB(B1, 0, 1); PG8_SCHED; PG8_LDA(At, 0, 0); PG8_STAGE(PG8_SA(1, 1), a1 + hstepA, voffA);
            PG8_WAIT_V(8); PG8_WAIT_L(0); PG8_BAR; PG8_MMA(0, 0, At, B0); PG8_MMA(0, 1, At, B1); PG8_BAR; PG8_SCHED;
            PG8_LDA(At, 0, 1); PG8_STAGE(PG8_SB(0, 0), b2, voffB); PG8_STAGE(PG8_SB(0, 1), b2 + hstepB, voffB); PG8_STAGE(PG8_SA(0, 0), a2, voffA);
            PG8_WAIT_V(8); PG8_WAIT_L(0); PG8_BAR; PG8_MMA(1, 0, At, B0); PG8_MMA(1, 1, At, B1); PG8_BAR; PG8_SCHED;
            PG8_LDB(B0, 1, 0); PG8_LDB(B1, 1, 1); PG8_SCHED; PG8_LDA(At, 1, 0); PG8_STAGE(PG8_SA(0, 1), a2 + hstepA, voffA);
            PG8_WAIT_V(8); PG8_WAIT_L(0); PG8_BAR; PG8_MMA(0, 0, At, B0); PG8_MMA(0, 1, At, B1); PG8_BAR; PG8_SCHED;
            PG8_LDA(At, 1, 1); PG8_STAGE(PG8_SB(1, 0), b3, voffB); PG8_STAGE(PG8_SB(1, 1), b3 + hstepB, voffB); PG8_STAGE(PG8_SA(1, 0), a3, voffA);
            PG8_WAIT_V(8); PG8_WAIT_L(0); PG8_BAR; PG8_MMA(1, 0, At, B0); PG8_MMA(1, 1, At, B1); PG8_BAR; PG8_SCHED;
        }
        if constexpr (ALIGN_EPI) { if (wr == 0) PG8_BAR; }
        if (cur.S == 0) { if constexpr (Epi::PRELOAD) { if (ui < PRE_UNITS) E(acc, cur, wr, wc, fr, fq, pre + ui * 512); else E(acc, cur, wr, wc, fr, fq); } else E(acc, cur, wr, wc, fr, fq); }
        else {
            float* sl = g.slab + (size_t)(cur.slot * cur.S + cur.ks) * 65536 + (size_t)(wr * 64 + fr) * 256 + wc * 32 + 8 * fq;
#pragma unroll
            for (int ai = 0; ai < 2; ++ai)
#pragma unroll
                for (int m = 0; m < 4; ++m)
#pragma unroll
                    for (int bj = 0; bj < 2; ++bj)
#pragma unroll
                        for (int n = 0; n < 2; ++n) *(f32x4*)(sl + (size_t)(ai * HALF + m * 16) * 256 + bj * HALF + 4 * n) = acc[ai][bj][m][n];
        }
        if (!has_next) break;
#pragma unroll
        for (int a = 0; a < 2; ++a)
#pragma unroll
            for (int b = 0; b < 2; ++b)
#pragma unroll
                for (int m = 0; m < 4; ++m)
#pragma unroll
                    for (int n = 0; n < 2; ++n) acc[a][b][m][n] = (f32x4){0.f, 0.f, 0.f, 0.f};
        cur = nxt; cA = nA; cB = nB; ++ui;
        if constexpr (ALIGN_EPI) { if (wr == 1) PG8_BAR; }
    }
    PG8_WAIT_V(0);
    if constexpr (!ALIGN_EPI) { if (wr == 0) PG8_BAR; }
    PG8_BAR;
#undef PG8_SA
#undef PG8_SB
#undef PG8_STAGE
#undef PG8_LDA
#undef PG8_LDB
#undef PG8_MMA
#undef PG8_WAIT_V
#undef PG8_WAIT_L
#undef PG8_BAR
#undef PG8_SCHED
}
}

__device__ __forceinline__ void transpose_item(const float* W, int K, int N, bf16_t* WT, int ldw, LAS float* scr, int item, int lane) {
    const int nblk = N / 32, kb = item / nblk, nb = item % nblk, k0 = 64 * kb, n0 = 32 * nb;
    float tv[32];
#pragma unroll
    for (int i = 0; i < 32; ++i) { const int kk = 2 * i + (lane >> 5); tv[i] = W[(size_t)(k0 + kk) * N + n0 + (lane & 31)]; }
#pragma unroll
    for (int i = 0; i < 32; ++i) { const int kk = 2 * i + (lane >> 5); scr[kk * 33 + (lane & 31)] = tv[i]; }
    asm volatile("s_waitcnt lgkmcnt(0)" ::: "memory");
    const int c = lane & 7;
#pragma unroll
    for (int j = 0; j < 4; ++j) { const int n = (lane >> 3) + 8 * j; const LAS float* s = scr + (8 * c) * 33 + n;
        u32x4 o; o.x = pk2(s[0 * 33], s[1 * 33]); o.y = pk2(s[2 * 33], s[3 * 33]); o.z = pk2(s[4 * 33], s[5 * 33]); o.w = pk2(s[6 * 33], s[7 * 33]);
        *(u32x4*)(WT + img_off(wrow_img((unsigned)(n0 + n)), (unsigned)(k0 + 8 * c), (unsigned)(K / 64))) = o; }
    asm volatile("s_waitcnt lgkmcnt(0)" ::: "memory");
}

__device__ __forceinline__ void transpose_layers(const Args& a, LAS unsigned char* lds, int l_lo, int l_hi, int wb, int nwb) {
    const int tid = opaque_tid(), lane = tid & 63, wave = tid >> 6, gw = wb * NWAVES + wave, ngw = nwb * NWAVES;
    LAS float* scr = (LAS float*)(lds + wave * 16384);
    constexpr int I_IN = (DM / 64) * (DIN / 32), I_OUT = (DM / 64) * (DM / 32), I_1 = (DM / 64) * (DFF / 32), I_2 = (DFF / 64) * (DM / 32), I_L = I_IN + I_OUT + I_1 + I_2;
    for (int it = l_lo * I_L + gw; it < l_hi * I_L; it += ngw) {
        const int l = it / I_L; int r = it % I_L;
        unsigned char* wl = a.ws + WS_WT + (size_t)l * WT_LAYER;
        if (r < I_IN) { transpose_item(a.in[8] + (size_t)l * DM * DIN, DM, DIN, (bf16_t*)(wl + WT_IN), DM, scr, r, lane); continue; } r -= I_IN;
        if (r < I_OUT) { transpose_item(a.in[26] + (size_t)l * DM * DM, DM, DM, (bf16_t*)(wl + WT_OUT), DM, scr, r, lane); continue; } r -= I_OUT;
        if (r < I_1) { transpose_item(a.in[27] + (size_t)l * DM * DFF, DM, DFF, (bf16_t*)(wl + WT_1), DM, scr, r, lane); continue; } r -= I_1;
        transpose_item(a.in[28] + (size_t)l * DFF * DM, DFF, DM, (bf16_t*)(wl + WT_2), HP, scr, r, lane);
    }
}

__device__ __forceinline__ void phase_p0a(const Args& a, LAS unsigned char* lds) {
    const int tid = opaque_tid(), lane = tid & 63, wave = tid >> 6, G = gridDim.x, bx = blockIdx.x;
    const float* c = a.in[1]; const float* c_ctx = a.in[3]; const float* w_mod = a.in[4]; const float* b_mod = a.in[5];
    float* mod = (float*)(a.ws + WS_MOD);
    LAS float* sil = (LAS float*)lds;
    LAS float* part = (LAS float*)(lds + 20480);
    if (bx < 192) {
        for (int idx = tid; idx < 5 * DM; idx += NTHREADS) { const int bb = idx >> 10, k = idx & 1023; const float v = bb < 4 ? c[bb * DM + k] : c_ctx[k]; sil[idx] = v / (1.0f + __expf(-v)); }
        __syncthreads();
        for (int unit = bx; unit < 192; unit += G) {
            const int l = unit / 48, nb = unit % 48, n = nb * 128 + 2 * lane;
            float acc[5][2];
#pragma unroll
            for (int bb = 0; bb < 5; ++bb) { acc[bb][0] = 0.f; acc[bb][1] = 0.f; }
            const float* wp = w_mod + ((size_t)l * DM + wave * 128) * NMODC + n;
#pragma unroll 1
            for (int k0 = 0; k0 < 128; k0 += 32) {
                f32x2 wv[32];
#pragma unroll
                for (int kk = 0; kk < 32; ++kk) wv[kk] = *(const f32x2*)(wp + (size_t)(k0 + kk) * NMODC);
#pragma unroll
                for (int kk = 0; kk < 32; ++kk) {
#pragma unroll
                    for (int bb = 0; bb < 5; ++bb) { const float sv = sil[bb * DM + wave * 128 + k0 + kk]; acc[bb][0] += sv * wv[kk][0]; acc[bb][1] += sv * wv[kk][1]; }
                }
            }
#pragma unroll
            for (int bb = 0; bb < 5; ++bb) { part[(wave * 5 + bb) * 128 + 2 * lane] = acc[bb][0]; part[(wave * 5 + bb) * 128 + 2 * lane + 1] = acc[bb][1]; }
            __syncthreads();
            for (int idx = tid; idx < 640; idx += NTHREADS) { const int bb = idx >> 7, cn = idx & 127; float s = b_mod[l * NMODC + nb * 128 + cn];
#pragma unroll
                for (int w = 0; w < 8; ++w) s += part[(w * 5 + bb) * 128 + cn];
                mod[((size_t)l * 5 + bb) * NMODC + nb * 128 + cn] = s; }
            __syncthreads();
        }
    }
    __syncthreads();
    {
        bf16_t* LW = (bf16_t*)(a.ws + WS_LW); bf16_t* SGW = (bf16_t*)(a.ws + WS_SGW); bf16_t* PW = (bf16_t*)(a.ws + WS_PW);
        for (int idx = bx * NTHREADS + tid; idx < 262144; idx += G * NTHREADS) {
            const int i = idx & 63, j = (idx >> 6) & 63, h = (idx >> 12) & 3, gate = (idx >> 14) & 1, dir = (idx >> 15) & 1, l = idx >> 16;
            LW[idx] = (bf16_t)f2bf((gate ? a.in[13] : a.in[11])[((size_t)((l * 2 + dir) * 4 + h) * 64 + i) * 64 + j]);
            SGW[idx] = (bf16_t)f2bf(a.in[20][idx]);
            if (idx < 65536) { const int g = (idx >> 12) & 3, l2 = idx >> 14; PW[idx] = (bf16_t)f2bf(a.in[16][((size_t)(l2 * 4 + g) * 64 + i) * 64 + j]); }
        }
    }
    transpose_layers(a, lds, 0, 1, bx, G);
}

__device__ __forceinline__ void sw_layers(const Args& a, int l_lo, int l_hi, int wb, int nwb) {
    const int tid = opaque_tid(), lane = tid & 63, gw = wb * NWAVES + (tid >> 6), NGW = nwb * NWAVES;
    const float* mod = (const float*)(a.ws + WS_MOD);
    constexpr int RL = DIN + DFF;
    for (int it0 = l_lo * RL + gw; it0 < l_hi * RL; it0 += 2 * NGW) {
        u32x4 wv[2][2]; const float* shp[2]; float* dstp[2]; int ldp[2]; bool okp[2];
#pragma unroll
        for (int u = 0; u < 2; ++u) {
            const int it = it0 + u * NGW; okp[u] = it < l_hi * RL; const int itc = okp[u] ? it : it0;
            const int l = itc / RL, r = itc % RL; const bool first = r < DIN; const int n = first ? r : r - DIN;
            const bf16_t* wbase = (const bf16_t*)(a.ws + WS_WT + (size_t)l * WT_LAYER + (first ? WT_IN : WT_1));
            const unsigned nimg = wrow_img((unsigned)n);
            wv[u][0] = *(const u32x4*)(wbase + img_off(nimg, 8u * lane, 16u)); wv[u][1] = *(const u32x4*)(wbase + img_off(nimg, 512u + 8u * lane, 16u));
            shp[u] = mod + (size_t)l * 5 * NMODC + (first ? 0 : 3) * DM;
            dstp[u] = first ? (float*)(a.ws + WS_SWIN) + (size_t)l * 5 * DIN + n : (float*)(a.ws + WS_SW1) + (size_t)l * 5 * DFF + n; ldp[u] = first ? DIN : DFF;
        }
#pragma unroll
        for (int u = 0; u < 2; ++u) {
            float acc[5] = {0.f, 0.f, 0.f, 0.f, 0.f};
#pragma unroll
            for (int hseg = 0; hseg < 2; ++hseg) {
                const int k0 = hseg * 512 + 8 * lane;
                float wf[8]; unpack8(wv[u][hseg], wf);
#pragma unroll
                for (int bb = 0; bb < 5; ++bb) {
                    const f32x4 s0 = *(const f32x4*)(shp[u] + (size_t)bb * NMODC + k0), s1 = *(const f32x4*)(shp[u] + (size_t)bb * NMODC + k0 + 4);
                    acc[bb] += s0[0] * wf[0] + s0[1] * wf[1] + s0[2] * wf[2] + s0[3] * wf[3] + s1[0] * wf[4] + s1[1] * wf[5] + s1[2] * wf[6] + s1[3] * wf[7];
                }
            }
#pragma unroll
            for (int bb = 0; bb < 5; ++bb) acc[bb] = wave_sum(acc[bb]);
            if (lane == 0 && okp[u]) {
#pragma unroll
                for (int bb = 0; bb < 5; ++bb) dstp[u][(size_t)bb * ldp[u]] = acc[bb];
            }
        }
    }
}

__device__ __forceinline__ void phase_p0b(const Args& a) {
    const int tid = opaque_tid(), lane = tid & 63, wave = tid >> 6, G = gridDim.x, bx = blockIdx.x;
    const float* mod = (const float*)(a.ws + WS_MOD);
    {
        float* TAB = (float*)(a.ws + WS_TAB);
        for (int idx = bx * NTHREADS + tid; idx < 8 * 5 * DM; idx += G * NTHREADS) {
            const int k = idx & 1023, bb = (idx >> 10) % 5, e = idx / (5 * DM), l = e >> 1, which = e & 1;
            const float* ml = mod + ((size_t)l * 5 + bb) * NMODC;
            const float g1 = gain_clamp(a.in[6][l * DM + k] * (1.0f + ml[DM + k])), g2 = gain_clamp(a.in[7][l * DM + k] * (1.0f + ml[4 * DM + k]));
            const float g1n = l < DEPTH - 1 ? gain_clamp(a.in[6][(l + 1) * DM + k] * (1.0f + mod[((size_t)(l + 1) * 5 + bb) * NMODC + DM + k])) : 1.0f;
            const float gp = which ? g2 : g1, gn = which ? g1n : g2, gate = ml[(which ? 5 : 2) * DM + k];
            float* t = TAB + (size_t)e * 15 * DM + (size_t)bb * DM + k;
            t[0] = gn / gp; t[5 * DM] = gate * gn; t[10 * DM] = 1.0f / gn;
        }
    }
    const int gw = bx * NWAVES + wave, NGW = G * NWAVES;
    sw_layers(a, 0, 1, bx, G);
    bf16_t* XG = (bf16_t*)(a.ws + WS_XG); float* ss = (float*)(a.ws + WS_SS);
    const float* g1 = a.in[6];
    float omega[4];
#pragma unroll
    for (int e = 0; e < 4; ++e) omega[e] = 1.0f / powf(10000.0f, (float)(4 * lane + e) * (1.0f / 256.0f));
    for (int r0 = gw; r0 < MTOT; r0 += 2 * NGW) {
        f32x4 v[2][4]; int rr[2]; bool okr[2];
#pragma unroll
        for (int u = 0; u < 2; ++u) {
            const int r = r0 + u * NGW; okr[u] = r < MTOT; rr[u] = okr[u] ? r : r0;
            const bool lat = rr[u] < MLAT;
            const float* src = lat ? a.in[0] + (size_t)rr[u] * DM : a.in[2] + (size_t)(rr[u] - MLAT) * DM;
#pragma unroll
            for (int j = 0; j < 4; ++j) v[u][j] = *(const f32x4*)(src + 256 * j + 4 * lane);
        }
#pragma unroll
        for (int u = 0; u < 2; ++u) {
            const int r = rr[u]; const bool lat = r < MLAT; const int bb = lat ? (r >> 12) : 4;
            const int t = r & 4095; const float prow = (float)(t >> 6), pcol = (float)(t & 63);
            float q = 0.f;
#pragma unroll
            for (int j = 0; j < 4; ++j) {
                const int k0 = 256 * j + 4 * lane;
                f32x4 vv = v[u][j];
                if (lat) {
#pragma unroll
                    for (int e = 0; e < 4; ++e) { const float ang = ((j < 2) ? prow : pcol) * omega[e]; vv[e] += (j & 1) ? __cosf(ang) : __sinf(ang); }
                }
                q += (vv[0] * vv[0] + vv[1] * vv[1]) + (vv[2] * vv[2] + vv[3] * vv[3]);
                const f32x4 gg = *(const f32x4*)(g1 + k0);
                const f32x4 sc = *(const f32x4*)(mod + (size_t)bb * NMODC + DM + k0);
                f32x4 gc = gg * (1.0f + sc);
#pragma unroll
                for (int e = 0; e < 4; ++e) gc[e] = gain_clamp(gc[e]);
                const f32x4 y = vv * gc;
                if (okr[u]) {
                    u32x2 w; w.x = pk2(y[0], y[1]); w.y = pk2(y[2], y[3]); *(u32x2*)(XG + img_off((unsigned)r, (unsigned)k0, 16u)) = w;
                }
            }
            q = wave_sum(q);
            if (lane < 16 && okr[u]) ss[(size_t)r * 16 + lane] = lane == 0 ? q : 0.f;
        }
    }
}

struct Tile { int rowbase, t0, seqlen, b; };
__device__ __forceinline__ Tile tile_of(int tt) {
    Tile T;
    if (tt < 128) { T.b = tt >> 5; T.rowbase = T.b * SEQ; T.t0 = (tt & 31) * 128; T.seqlen = SEQ; }
    else { const int j = tt - 128; T.b = j >> 1; T.rowbase = MLAT + T.b * CTXL; T.t0 = (j & 1) * 128; T.seqlen = CTXL; }
    return T;
}

constexpr int CXS = 264;
constexpr int VTS = 136;
constexpr int TILE_B = 128 * CXS * 2;
__device__ __forceinline__ float frcp(float x) { return __builtin_amdgcn_rcpf(x); }
__device__ __forceinline__ float fsig(float x) { return frcp(1.0f + __expf(-x)); }
__device__ __forceinline__ float fgelu(float x) { const float u = 0.7978845608028654f * (x + 0.044715f * x * x * x); return 0.5f * x * (2.0f - 2.0f * frcp(__expf(2.0f * u) + 1.0f)); }

template <int NROWS, int STRIDE>
__device__ __forceinline__ void fill_tile(LAS bf16_t* dst, const bf16_t* PX, const Tile& T, int tok0, int col) {
    const int tid = opaque_tid();
    constexpr int NIT = (NROWS * 32 + NTHREADS - 1) / NTHREADS;
    u32x4 v[NIT];
#pragma unroll
    for (int it = 0; it < NIT; ++it) {
        const int idx = min(tid + NTHREADS * it, NROWS * 32 - 1), r = idx >> 5, vec = idx & 31, tg = T.t0 + tok0 + r, tgc = min(max(tg, 0), T.seqlen - 1);
        v[it] = *(const u32x4*)(PX + (size_t)(T.rowbase + tgc) * DIN + col + vec * 8);
    }
#pragma unroll
    for (int it = 0; it < NIT; ++it) {
        const int idx = tid + NTHREADS * it, r = idx >> 5, vec = idx & 31, tg = T.t0 + tok0 + r;
        const bool ok = tg >= 0 && tg < T.seqlen;
        u32x4 o = v[it]; if (!ok) o = (u32x4){0u, 0u, 0u, 0u};
        if (idx < NROWS * 32) *(LAS u32x4*)(dst + r * STRIDE + vec * 8) = o;
    }
}
__device__ __forceinline__ void flush_tile(const LAS bf16_t* src, bf16_t* MIX, const Tile& T, int col) {
    const int tid = opaque_tid();
#pragma unroll
    for (int it = 0; it < 8; ++it) {
        const int idx = tid + NTHREADS * it, r = idx >> 5, vec = idx & 31;
        *(u32x4*)(MIX + img_off((unsigned)(T.rowbase + T.t0 + r), (unsigned)(col + vec * 8), 16u)) = *(const LAS u32x4*)(src + r * CXS + vec * 8);
    }
}

__device__ __forceinline__ void lru_conv_tile(const Args& a, LAS bf16_t* cxb, int l, const Tile& T) {
    const int tid = opaque_tid(), vec = tid & 31, grp = tid >> 5, c0 = vec * 8;
    const bf16_t* PX = (const bf16_t*)(a.ws + WS_PX);
    const float* caw = a.in[9] + (size_t)l * 4 * 256; const float* cab = a.in[10] + (size_t)l * 256;
    u32x4 raw[11];
#pragma unroll
    for (int i = 0; i < 11; ++i) { const int tg = T.t0 + grp * 8 + i - 2, tgc = min(max(tg, 0), T.seqlen - 1); raw[i] = *(const u32x4*)(PX + (size_t)(T.rowbase + tgc) * DIN + c0); }
    float w[4][8], bias[8], win[4][8];
#pragma unroll
    for (int k = 0; k < 4; ++k) { const f32x4 w0 = *(const f32x4*)(caw + k * 256 + c0), w1 = *(const f32x4*)(caw + k * 256 + c0 + 4);
#pragma unroll
        for (int e = 0; e < 4; ++e) { w[k][e] = w0[e]; w[k][4 + e] = w1[e]; } }
    { const f32x4 b0 = *(const f32x4*)(cab + c0), b1 = *(const f32x4*)(cab + c0 + 4);
#pragma unroll
      for (int e = 0; e < 4; ++e) { bias[e] = b0[e]; bias[4 + e] = b1[e]; } }
#pragma unroll
    for (int k = 0; k < 4; ++k)
#pragma unroll
        for (int e = 0; e < 8; ++e) win[k][e] = 0.f;
#pragma unroll
    for (int i = 0; i < 11; ++i) {
        const int tg = T.t0 + grp * 8 + i - 2;
        u32x4 rv = raw[i]; if (!(tg >= 0 && tg < T.seqlen)) rv = (u32x4){0u, 0u, 0u, 0u};
#pragma unroll
        for (int e = 0; e < 8; ++e) { win[0][e] = win[1][e]; win[1][e] = win[2][e]; win[2][e] = win[3][e]; }
        unpack8(rv, win[3]);
        if (i >= 3) {
            float o[8];
#pragma unroll
            for (int e = 0; e < 8; ++e) o[e] = bias[e] + w[0][e] * win[0][e] + w[1][e] * win[1][e] + w[2][e] * win[2][e] + w[3][e] * win[3][e];
            *(LAS u32x4*)(cxb + (grp * 8 + i - 3) * CXS + c0) = pack8(o);
        }
    }
}

__device__ __forceinline__ void lru_carries(const Args& a, LAS float* carry, int tt, const Tile& T) {
    const int tid = opaque_tid(), dir = tid >> 8, ch = tid & 255;
    const float* SUM = (const float*)(a.ws + WS_SUM);
    int pos;
    if (tt < 128) { const int i = tt & 31; pos = 2 + (dir ? 31 - i : i); } else { const int jj = (tt - 128) & 1; pos = dir ? 1 - jj : jj; }
    f32x2 sm[33];
#pragma unroll
    for (int p = 0; p < 33; ++p) {
        const int pc = p < pos ? p : 0;
        int t2;
        if (pc < 2) t2 = 128 + 2 * T.b + (dir ? 1 - pc : pc); else t2 = 32 * T.b + (dir ? 31 - (pc - 2) : (pc - 2));
        sm[p] = *(const f32x2*)(SUM + ((size_t)(t2 * 2 + dir) * 256 + ch) * 2);
    }
    float hst = 0.f;
#pragma unroll
    for (int p = 0; p < 33; ++p) if (p < pos) hst = sm[p][0] * hst + sm[p][1];
    carry[tid] = hst;
}

template <int DIR, int MODE>
__device__ __forceinline__ void lru_pass(const Args& a, const LAS bf16_t* cxb, LAS bf16_t* gyb, const LAS float* carry, const bf16x8 (&Bw)[2][2][2], const float (&prm)[2][3], int l, int tt, float (&hf)[8][2][4]) {
    const int tid = opaque_tid(), lane = tid & 63, w = __builtin_amdgcn_readfirstlane(tid >> 6), h = w & 3, nh = w >> 2, fr = lane & 15, fq = lane >> 4;
    float* SUM = (float*)(a.ws + WS_SUM);
    float ba[2], bxv[2], k8[2], C[2], At[2]; int cc[2];
#pragma unroll
    for (int nt = 0; nt < 2; ++nt) {
        const int c = 64 * h + 32 * nh + 16 * nt + fr; cc[nt] = c;
        ba[nt] = prm[nt][0]; bxv[nt] = prm[nt][1]; k8[nt] = prm[nt][2];
        C[nt] = MODE == 1 ? carry[DIR * 256 + c] : 0.f; At[nt] = 1.f;
    }
#pragma unroll
    for (int mi = 0; mi < 8; ++mi) {
        const int m = DIR ? 7 - mi : mi;
        bf16x8 Af[2];
#pragma unroll
        for (int ks = 0; ks < 2; ++ks) Af[ks] = *(const LAS bf16x8*)(cxb + (m * 16 + fr) * CXS + 64 * h + 32 * ks + 8 * fq);
#pragma unroll
        for (int nt = 0; nt < 2; ++nt) {
            f32x4 pr = (f32x4){0.f, 0.f, 0.f, 0.f}, pi = (f32x4){0.f, 0.f, 0.f, 0.f};
#pragma unroll
            for (int ks = 0; ks < 2; ++ks) { pr = __builtin_amdgcn_mfma_f32_16x16x32_bf16(Af[ks], Bw[0][nt][ks], pr, 0, 0, 0); pi = __builtin_amdgcn_mfma_f32_16x16x32_bf16(Af[ks], Bw[1][nt][ks], pi, 0, 0, 0); }
            float av[4], bv[4];
#pragma unroll
            for (int reg = 0; reg < 4; ++reg) {
                const int tok = m * 16 + 4 * fq + reg;
                const float x = bf2f(cxb[tok * CXS + cc[nt]]);
                const float r = fsig(pr[reg] + ba[nt]), ig = fsig(pi[reg] + bxv[nt]);
                const float aa = __expf(k8[nt] * r);
                av[reg] = aa; bv[reg] = __builtin_amdgcn_sqrtf(fmaxf(1.0f - aa * aa, 0.f)) * ig * x;
            }
            float cum[4], hl[4];
            if (DIR == 0) { cum[0] = av[0]; hl[0] = bv[0];
#pragma unroll
                for (int reg = 1; reg < 4; ++reg) { cum[reg] = cum[reg - 1] * av[reg]; hl[reg] = av[reg] * hl[reg - 1] + bv[reg]; } }
            else { cum[3] = av[3]; hl[3] = bv[3];
#pragma unroll
                for (int reg = 2; reg >= 0; --reg) { cum[reg] = cum[reg + 1] * av[reg]; hl[reg] = av[reg] * hl[reg + 1] + bv[reg]; } }
            const float A4 = DIR ? cum[0] : cum[3], H4 = DIR ? hl[0] : hl[3];
            float Aq[4], Hq[4];
#pragma unroll
            for (int q = 0; q < 4; ++q) { Aq[q] = __shfl(A4, fr + 16 * q); Hq[q] = __shfl(H4, fr + 16 * q); }
            float hin;
            if (DIR == 0) { const float s0 = C[nt], s1 = Aq[0] * s0 + Hq[0], s2 = Aq[1] * s1 + Hq[1], s3 = Aq[2] * s2 + Hq[2]; C[nt] = Aq[3] * s3 + Hq[3]; hin = fq == 0 ? s0 : (fq == 1 ? s1 : (fq == 2 ? s2 : s3)); }
            else { const float s3 = C[nt], s2 = Aq[3] * s3 + Hq[3], s1 = Aq[2] * s2 + Hq[2], s0 = Aq[1] * s1 + Hq[1]; C[nt] = Aq[0] * s0 + Hq[0]; hin = fq == 3 ? s3 : (fq == 2 ? s2 : (fq == 1 ? s1 : s0)); }
            if (MODE == 0) At[nt] *= (Aq[0] * Aq[1]) * (Aq[2] * Aq[3]);
            else {
#pragma unroll
                for (int reg = 0; reg < 4; ++reg) {
                    const float hv = hl[reg] + cum[reg] * hin;
                    if (DIR == 0) hf[m][nt][reg] = hv;
                    else { LAS bf16_t* gp = gyb + (m * 16 + 4 * fq + reg) * CXS + cc[nt];
                        const float g = bf2f(*gp);
                        *gp = (bf16_t)f2bf((hf[m][nt][reg] + hv) * fgelu(g)); }
                }
            }
        }
    }
    if (MODE == 0 && fq == 0) {
#pragma unroll
        for (int nt = 0; nt < 2; ++nt) { f32x2 sm; sm[0] = At[nt]; sm[1] = C[nt]; *(f32x2*)(SUM + ((size_t)(tt * 2 + DIR) * 256 + cc[nt]) * 2) = sm; }
    }
}

template <int MODE>
__device__ __forceinline__ void lru_unit(const Args& a, LAS unsigned char* lds, int l, int tt) {
    const Tile T = tile_of(tt);
    LAS bf16_t* cxb = (LAS bf16_t*)lds;
    LAS bf16_t* gyb = (LAS bf16_t*)(lds + TILE_B);
    LAS float* carry = (LAS float*)(lds + 2 * TILE_B);
    const int tid = opaque_tid(), lane = tid & 63, w = __builtin_amdgcn_readfirstlane(tid >> 6), h = w & 3, nh = w >> 2, fr = lane & 15, fq = lane >> 4;
    const bf16_t* LW = (const bf16_t*)(a.ws + WS_LW);
    bf16x8 Bw0[2][2][2], Bw1[2][2][2];
#pragma unroll
    for (int g = 0; g < 2; ++g)
#pragma unroll
        for (int nt = 0; nt < 2; ++nt)
#pragma unroll
            for (int ks = 0; ks < 2; ++ks) {
                Bw0[g][nt][ks] = *(const bf16x8*)(LW + ((size_t)((((l * 2 + 0) * 2 + g) * 4 + h) * 64 + 32 * nh + 16 * nt + fr)) * 64 + 32 * ks + 8 * fq);
                Bw1[g][nt][ks] = *(const bf16x8*)(LW + ((size_t)((((l * 2 + 1) * 2 + g) * 4 + h) * 64 + 32 * nh + 16 * nt + fr)) * 64 + 32 * ks + 8 * fq);
            }
    float prm0[2][3], prm1[2][3];
#pragma unroll
    for (int nt = 0; nt < 2; ++nt) {
        const int c = 64 * h + 32 * nh + 16 * nt + fr;
        prm0[nt][0] = a.in[12][(l * 2 + 0) * 256 + c]; prm0[nt][1] = a.in[14][(l * 2 + 0) * 256 + c]; prm0[nt][2] = a.in[15][(l * 2 + 0) * 256 + c];
        prm1[nt][0] = a.in[12][(l * 2 + 1) * 256 + c]; prm1[nt][1] = a.in[14][(l * 2 + 1) * 256 + c]; prm1[nt][2] = a.in[15][(l * 2 + 1) * 256 + c];
    }
    if (MODE == 1) { lru_carries(a, carry, tt, T); fill_tile<128, CXS>(gyb, (const bf16_t*)(a.ws + WS_PX), T, 0, 256); }
    lru_conv_tile(a, cxb, l, T);
#pragma unroll
    for (int nt = 0; nt < 2; ++nt) { prm0[nt][2] = -8.0f * log1pf(__expf(-prm0[nt][2])); prm1[nt][2] = -8.0f * log1pf(__expf(-prm1[nt][2])); }
    __syncthreads();
    float hf[8][2][4];
    lru_pass<0, MODE>(a, cxb, gyb, carry, Bw0, prm0, l, tt, hf);
    lru_pass<1, MODE>(a, cxb, gyb, carry, Bw1, prm1, l, tt, hf);
    __syncthreads();
    if (MODE == 1) { flush_tile(gyb, (bf16_t*)(a.ws + WS_MIX), T, 0); __syncthreads(); }
}

template <int WIN>
__device__ __forceinline__ void pool_p_run(const LAS unsigned* Zu, LAS bf16_t* P, int g, int cpi, int run, const Tile& T) {
    constexpr int LO = WIN / 2, HI = WIN - LO - 1, NZ = 32 + WIN - 1;
    const int cp = g * 32 + cpi, ts = run * 32;
    unsigned z[NZ];
#pragma unroll
    for (int j = 0; j < NZ; ++j) z[j] = Zu[(ts - LO + j + 8) * 128 + cp];
    float s0 = 0.f, s1 = 0.f;
#pragma unroll
    for (int j = 0; j < WIN; ++j) { s0 += bf2f(z[j] & 0xffffu); s1 += __builtin_bit_cast(float, z[j] & 0xffff0000u); }
#pragma unroll
    for (int tt = 0; tt < 32; ++tt) {
        const int t = ts + tt, tg = T.t0 + t;
        const float inv = frcp((float)(min(tg + HI + 1, T.seqlen) - max(tg - LO, 0)));
        const unsigned cv = z[tt + LO];
        *(LAS unsigned*)(P + t * CXS + 2 * cp) = pk2(s0 * inv - bf2f(cv & 0xffffu), s1 * inv - __builtin_bit_cast(float, cv & 0xffff0000u));
        if (tt < 31) { s0 += bf2f(z[tt + WIN] & 0xffffu) - bf2f(z[tt] & 0xffffu); s1 += __builtin_bit_cast(float, z[tt + WIN] & 0xffff0000u) - __builtin_bit_cast(float, z[tt] & 0xffff0000u); }
    }
}

__device__ __forceinline__ void pool_unit(const Args& a, LAS unsigned char* lds, int l, int tt) {
    const int tid = opaque_tid(), lane = tid & 63, w = __builtin_amdgcn_readfirstlane(tid >> 6), fr = lane & 15, fq = lane >> 4;
    const Tile T = tile_of(tt);
    LAS bf16_t* Z = (LAS bf16_t*)lds;
    LAS bf16_t* P = (LAS bf16_t*)(lds + 144 * 512);
    const int g = w & 3, mh = w >> 2;
    const bf16_t* PW = (const bf16_t*)(a.ws + WS_PW);
    bf16x8 Bw[4][2];
#pragma unroll
    for (int nt = 0; nt < 4; ++nt)
#pragma unroll
        for (int ks = 0; ks < 2; ++ks) Bw[nt][ks] = *(const bf16x8*)(PW + ((size_t)((l * 4 + g) * 64 + 16 * nt + fr)) * 64 + 32 * ks + 8 * fq);
    float sc[4];
#pragma unroll
    for (int nt = 0; nt < 4; ++nt) sc[nt] = a.in[17][l * 256 + 64 * g + 16 * nt + fr];
    fill_tile<144, 256>(Z, (const bf16_t*)(a.ws + WS_PX), T, -8, 512);
    __syncthreads();
    {
        const LAS unsigned* Zu = (const LAS unsigned*)Z;
        const int gg = __builtin_amdgcn_readfirstlane(tid >> 7), cpi = tid & 31, run = (tid >> 5) & 3;
        if (gg == 0) pool_p_run<2>(Zu, P, gg, cpi, run, T);
        else if (gg == 1) pool_p_run<4>(Zu, P, gg, cpi, run, T);
        else if (gg == 2) pool_p_run<8>(Zu, P, gg, cpi, run, T);
        else pool_p_run<16>(Zu, P, gg, cpi, run, T);
    }
    __syncthreads();
#pragma unroll
    for (int mm = 0; mm < 4; ++mm) {
        const int m = mh * 4 + mm;
        bf16x8 Af[2];
#pragma unroll
        for (int ks = 0; ks < 2; ++ks) Af[ks] = *(const LAS bf16x8*)(P + (m * 16 + fr) * CXS + 64 * g + 32 * ks + 8 * fq);
#pragma unroll
        for (int nt = 0; nt < 4; ++nt) {
            f32x4 acc = (f32x4){0.f, 0.f, 0.f, 0.f};
#pragma unroll
            for (int ks = 0; ks < 2; ++ks) acc = __builtin_amdgcn_mfma_f32_16x16x32_bf16(Af[ks], Bw[nt][ks], acc, 0, 0, 0);
#pragma unroll
            for (int reg = 0; reg < 4; ++reg) Z[(m * 16 + 4 * fq + reg) * CXS + 64 * g + 16 * nt + fr] = (bf16_t)f2bf(acc[reg] * sc[nt]);
        }
    }
    __syncthreads();
    flush_tile(Z, (bf16_t*)(a.ws + WS_MIX), T, 256);
    __syncthreads();
}

__device__ __forceinline__ void sgu_unit(const Args& a, LAS unsigned char* lds, int l, int tt) {
    const int tid = opaque_tid(), lane = tid & 63, w = __builtin_amdgcn_readfirstlane(tid >> 6), fr = lane & 15, fq = lane >> 4;
    const Tile T = tile_of(tt);
    constexpr int REGA = 256 * VTS * 2;
    LAS bf16_t* Vb = (LAS bf16_t*)lds;
    LAS bf16_t* vnT = (LAS bf16_t*)lds;
    LAS bf16_t* Ub = (LAS bf16_t*)(lds + REGA);
    LAS f32x2* stats = (LAS f32x2*)(lds + REGA + TILE_B);
    const int h = w & 3, mh = w >> 2;
    const bf16_t* SGW = (const bf16_t*)(a.ws + WS_SGW) + (size_t)(l * 4 + h) * 128 * 128;
    const float* bsh = a.in[21] + (size_t)(l * 4 + h) * 128;
    bf16x8 Aw[4][4]; f32x4 bsv[4];
#pragma unroll
    for (int mm = 0; mm < 4; ++mm) {
        bsv[mm] = *(const f32x4*)(bsh + (mh * 4 + mm) * 16 + 4 * fq);
#pragma unroll
        for (int ks = 0; ks < 4; ++ks) Aw[mm][ks] = *(const bf16x8*)(SGW + (size_t)((mh * 4 + mm) * 16 + fr) * 128 + 32 * ks + 8 * fq);
    }
    fill_tile<128, CXS>(Vb, (const bf16_t*)(a.ws + WS_PX), T, 0, 1024);
    fill_tile<128, CXS>(Ub, (const bf16_t*)(a.ws + WS_PX), T, 0, 768);
    __syncthreads();
    {
        const int row = tid >> 2, seg = tid & 3;
        float v[8][8]; float s = 0.f;
#pragma unroll
        for (int j = 0; j < 8; ++j) { unpack8(*(const LAS u32x4*)(Vb + row * CXS + 64 * seg + 8 * j), v[j]);
#pragma unroll
            for (int e = 0; e < 8; ++e) s += v[j][e]; }
        s += __shfl_xor(s, 1); s += __shfl_xor(s, 2);
        const float mu = s * (1.0f / 256.0f);
        float q = 0.f;
#pragma unroll
        for (int j = 0; j < 8; ++j) {
#pragma unroll
            for (int e = 0; e < 8; ++e) v[j][e] -= mu;
            q += sum8sq(v[j]); }
        q += __shfl_xor(q, 1); q += __shfl_xor(q, 2);
        if (seg == 0) { f32x2 st; st[0] = mu; st[1] = __builtin_amdgcn_rsqf(q * (1.0f / 256.0f) + EPS); stats[row] = st; }
    }
    __syncthreads();
    {
        const int c = tid & 255, q0 = (tid >> 8) * 64;
        const float lg = a.in[18][l * 256 + c], lb = a.in[19][l * 256 + c];
        u32x4 pk[8];
#pragma unroll
        for (int j = 0; j < 8; ++j) {
            float y[8];
#pragma unroll
            for (int e = 0; e < 8; ++e) { const int q = q0 + 8 * j + e; const f32x2 st = stats[q]; y[e] = (bf2f(Vb[q * CXS + c]) - st[0]) * st[1] * lg + lb; }
            pk[j] = pack8(y);
        }
        __syncthreads();
#pragma unroll
        for (int j = 0; j < 8; ++j) *(LAS u32x4*)(vnT + c * VTS + q0 + 8 * j) = pk[j];
    }
    __syncthreads();
#pragma unroll
    for (int nt = 0; nt < 4; ++nt) {
        const int c = 64 * h + 16 * nt + fr;
        bf16x8 Bf[4];
#pragma unroll
        for (int ks = 0; ks < 4; ++ks) Bf[ks] = *(const LAS bf16x8*)(vnT + c * VTS + 32 * ks + 8 * fq);
#pragma unroll
        for (int mm = 0; mm < 4; ++mm) {
            f32x4 acc = (f32x4){0.f, 0.f, 0.f, 0.f};
#pragma unroll
            for (int ks = 0; ks < 4; ++ks) acc = __builtin_amdgcn_mfma_f32_16x16x32_bf16(Aw[mm][ks], Bf[ks], acc, 0, 0, 0);
#pragma unroll
            for (int reg = 0; reg < 4; ++reg) { LAS bf16_t* up = Ub + ((mh * 4 + mm) * 16 + 4 * fq + reg) * CXS + c;
                *up = (bf16_t)f2bf(bf2f(*up) * (acc[reg] + bsv[mm][reg])); }
        }
    }
    __syncthreads();
    flush_tile(Ub, (bf16_t*)(a.ws + WS_MIX), T, 512);
    __syncthreads();
}

__device__ __forceinline__ void conv_unit(const Args& a, LAS unsigned char* lds, int l, int tt) {
    const int tid = opaque_tid();
    const Tile T = tile_of(tt);
    const bf16_t* PX = (const bf16_t*)(a.ws + WS_PX); bf16_t* MIX = (bf16_t*)(a.ws + WS_MIX);
    LAS bf16_t* Y = (LAS bf16_t*)lds;
    LAS bf16_t* O = (LAS bf16_t*)(lds + 158 * 512);
    LAS float* lnp = (LAS float*)(lds + 158 * 512 + TILE_B);
    lnp[tid] = tid < 256 ? a.in[24][l * 256 + tid] : a.in[25][l * 256 + tid - 256];
#pragma unroll 1
    for (int hb = 0; hb < 2; ++hb) {
        u32x4 vv[5], vg[5];
#pragma unroll
        for (int it = 0; it < 5; ++it) {
            const int idx = min(tid + NTHREADS * (hb * 5 + it), 158 * 32 - 1), s = idx >> 5, vec = idx & 31, tg = T.t0 - 15 + s, tgc = min(max(tg, 0), T.seqlen - 1);
            const size_t row = (size_t)(T.rowbase + tgc);
            vv[it] = *(const u32x4*)(PX + row * DIN + 1280 + vec * 8); vg[it] = *(const u32x4*)(PX + row * DIN + 1536 + vec * 8);
        }
#pragma unroll
        for (int it = 0; it < 5; ++it) {
            const int idx = tid + NTHREADS * (hb * 5 + it), s = idx >> 5, vec = idx & 31, tg = T.t0 - 15 + s;
            float cv[8], cgt[8];
            unpack8(vv[it], cv); unpack8(vg[it], cgt);
            const bool ok = tg >= 0 && tg < T.seqlen;
#pragma unroll
            for (int e = 0; e < 8; ++e) cv[e] = ok ? cv[e] * fsig(cgt[e]) : 0.f;
            if (idx < 158 * 32) *(LAS u32x4*)(Y + s * 256 + vec * 8) = pack8(cv);
        }
    }
    __syncthreads();
    {
        const int cp = tid & 127, tg4 = tid >> 7;
        float w0[31], w1[31];
#pragma unroll
        for (int k = 0; k < 31; ++k) { const f32x2 wv = *(const f32x2*)(a.in[22] + ((size_t)l * 31 + k) * 256 + 2 * cp); w0[k] = wv[0]; w1[k] = wv[1]; }
        const f32x2 cb = *(const f32x2*)(a.in[23] + l * 256 + 2 * cp);
        const LAS unsigned* Yu = (const LAS unsigned*)Y;
#pragma unroll 1
        for (int half = 0; half < 2; ++half) {
            const int tb = (tg4 + 4 * half) * 16;
            float a0[16], a1[16];
#pragma unroll
            for (int t = 0; t < 16; ++t) { a0[t] = cb[0]; a1[t] = cb[1]; }
#pragma unroll
            for (int r = 0; r < 46; ++r) {
                const unsigned wv = Yu[(tb + r) * 128 + cp];
                const float x0 = bf2f(wv & 0xffffu), x1 = __builtin_bit_cast(float, wv & 0xffff0000u);
#pragma unroll
                for (int t = 0; t < 16; ++t) { const int k = r - t; if (k >= 0 && k <= 30) { a0[t] += w0[k] * x0; a1[t] += w1[k] * x1; } }
            }
#pragma unroll
            for (int t = 0; t < 16; ++t) *(LAS unsigned*)(O + (tb + t) * CXS + 2 * cp) = pk2(a0[t], a1[t]);
        }
    }
    __syncthreads();
    {
        const int row = tid >> 2, seg = tid & 3;
        float v[8][8]; float s = 0.f;
#pragma unroll
        for (int j = 0; j < 8; ++j) { unpack8(*(const LAS u32x4*)(O + row * CXS + 64 * seg + 8 * j), v[j]);
#pragma unroll
            for (int e = 0; e < 8; ++e) s += v[j][e]; }
        s += __shfl_xor(s, 1); s += __shfl_xor(s, 2);
        const float mu = s * (1.0f / 256.0f);
        float q = 0.f;
#pragma unroll
        for (int j = 0; j < 8; ++j) {
#pragma unroll
            for (int e = 0; e < 8; ++e) v[j][e] -= mu;
            q += sum8sq(v[j]); }
        q += __shfl_xor(q, 1); q += __shfl_xor(q, 2);
        const float rstd = __builtin_amdgcn_rsqf(q * (1.0f / 256.0f) + EPS);
        const LAS float* lgp = lnp + 64 * seg; const LAS float* lbp = lnp + 256 + 64 * seg;
        bf16_t* dst = MIX + img_off((unsigned)(T.rowbase + T.t0 + row), (unsigned)(768 + 64 * seg), 16u);
        const unsigned rl_ = (unsigned)((T.t0 + row) & 127), h0_ = hl_off(rl_, 0u);
#pragma unroll
        for (int j = 0; j < 8; ++j) {
            const f32x4 g0 = *(const LAS f32x4*)(lgp + 8 * j), g1 = *(const LAS f32x4*)(lgp + 8 * j + 4), b0 = *(const LAS f32x4*)(lbp + 8 * j), b1 = *(const LAS f32x4*)(lbp + 8 * j + 4);
            float y[8];
#pragma unroll
            for (int e = 0; e < 4; ++e) { y[e] = v[j][e] * rstd * g0[e] + b0[e]; y[4 + e] = v[j][4 + e] * rstd * g1[e] + b1[e]; }
#pragma unroll
            for (int e = 0; e < 8; ++e) y[e] = y[e] * fsig(y[e]);
            *(u32x4*)(dst + ((int)hl_off(rl_, 8u * j) - (int)h0_)) = pack8(y);
        }
    }
    __syncthreads();
}


template <int S>
__device__ __forceinline__ void finish_ctx(const Args& a, const float* slab, const float* tab) {
    const int tid = opaque_tid(), lane = tid & 63, wave = tid >> 6;
    const int gw = blockIdx.x * NWAVES + wave, NGW = gridDim.x * NWAVES;
    bf16_t* XG = (bf16_t*)(a.ws + WS_XG); float* ss = (float*)(a.ws + WS_SS);
    for (int item0 = gw; item0 < MCTX * 4; item0 += 2 * NGW) {
        f32x4 pv[2][S]; u32x2 xr[2]; f32x4 vr[2], vt[2], vi[2]; bool ok[2]; unsigned off[2]; size_t row[2]; int pnv[2];
#pragma unroll
        for (int u = 0; u < 2; ++u) {
            const int item = item0 + u * NGW; ok[u] = item < MCTX * 4; const int ic = ok[u] ? item : item0;
            const int rl = ic >> 2, pn = ic & 3, slot = (rl >> 8) * 4 + pn, rin = rl & 255, col = pn * 256 + 4 * lane;
            pnv[u] = pn; row[u] = (size_t)(MLAT + rl); off[u] = img_off((unsigned)(MLAT + rl), (unsigned)col, 16u);
#pragma unroll
            for (int ks = 0; ks < S; ++ks) pv[u][ks] = *(const f32x4*)(slab + (size_t)(slot * S + ks) * 65536 + (size_t)rin * 256 + 4 * lane);
            xr[u] = *(const u32x2*)(XG + off[u]);
            const float* tp = tab + (size_t)4 * DM + col;
            vr[u] = *(const f32x4*)tp; vt[u] = *(const f32x4*)(tp + 5 * DM); vi[u] = *(const f32x4*)(tp + 10 * DM);
        }
#pragma unroll
        for (int u = 0; u < 2; ++u) {
            f32x4 sum = pv[u][0];
#pragma unroll
            for (int ks = 1; ks < S; ++ks) sum += pv[u][ks];
            f32x4 x; x[0] = bf2f(xr[u].x & 0xffffu); x[1] = __builtin_bit_cast(float, xr[u].x & 0xffff0000u); x[2] = bf2f(xr[u].y & 0xffffu); x[3] = __builtin_bit_cast(float, xr[u].y & 0xffff0000u);
            const f32x4 y = x * vr[u] + vt[u] * sum, z = y * vi[u];
            const float q = wave_sum((z[0] * z[0] + z[1] * z[1]) + (z[2] * z[2] + z[3] * z[3]));
            if (ok[u]) {
                u32x2 w; w.x = pk2(y[0], y[1]); w.y = pk2(y[2], y[3]); *(u32x2*)(XG + off[u]) = w;
                if (lane < 4) ss[row[u] * 16 + pnv[u] * 4 + lane] = lane == 0 ? q : 0.f;
            }
        }
    }
}

__device__ __forceinline__ void phase_final(const Args& a) {
    const int tid = opaque_tid(), lane = tid & 63, wave = tid >> 6;
    const int gw = blockIdx.x * NWAVES + wave, NGW = gridDim.x * NWAVES;
    const bf16_t* X = (const bf16_t*)(a.ws + WS_XG); const float* gf = a.in[29];
    for (int r0 = gw; r0 < MLAT; r0 += 2 * NGW) {
        u32x2 xr[2][4]; bool okr[2];
#pragma unroll
        for (int u = 0; u < 2; ++u) { const int r = r0 + u * NGW; okr[u] = r < MLAT; const int rc = okr[u] ? r : r0;
#pragma unroll
            for (int j = 0; j < 4; ++j) xr[u][j] = *(const u32x2*)(X + img_off((unsigned)rc, (unsigned)(256 * j + 4 * lane), 16u)); }
#pragma unroll
        for (int u = 0; u < 2; ++u) {
            const int r = r0 + u * NGW;
            f32x4 v[4]; float q = 0.f;
#pragma unroll
            for (int j = 0; j < 4; ++j) { v[j][0] = bf2f(xr[u][j].x & 0xffffu); v[j][1] = __builtin_bit_cast(float, xr[u][j].x & 0xffff0000u); v[j][2] = bf2f(xr[u][j].y & 0xffffu); v[j][3] = __builtin_bit_cast(float, xr[u][j].y & 0xffff0000u);
                q += (v[j][0] * v[j][0] + v[j][1] * v[j][1]) + (v[j][2] * v[j][2] + v[j][3] * v[j][3]); }
            const float rs = 1.0f / sqrtf(wave_sum(q) * (1.0f / DM) + EPS);
            if (okr[u]) {
#pragma unroll
                for (int j = 0; j < 4; ++j) { const f32x4 g = *(const f32x4*)(gf + 256 * j + 4 * lane); *(f32x4*)(a.out + (size_t)r * DM + 256 * j + 4 * lane) = v[j] * rs * g; }
            }
        }
    }
}

#define XB_TMO      128
#define XB_XCNT(j)  (256  + 64 * (j))
#define XB_XSUB(j)  (1280 + 64 * (j))
#define XB_XGEN(j)  (2304 + 64 * (j))
#define XB_TOP      3328
#define XB_TOPGEN   3392
#define XCD_BAR_WORDS 3456
#define XB_SPIN_CAP (1u << 18)

__device__ __forceinline__ unsigned xb_ld(unsigned* p)              { return __hip_atomic_load(p, __ATOMIC_RELAXED, __HIP_MEMORY_SCOPE_AGENT); }
__device__ __forceinline__ unsigned xb_add(unsigned* p, unsigned v) { return __hip_atomic_fetch_add(p, v, __ATOMIC_RELAXED, __HIP_MEMORY_SCOPE_AGENT); }
__device__ __forceinline__ unsigned xb_xcc_id() { return (unsigned)__builtin_amdgcn_s_getreg((3 << 11) | 20) & 0xFu; }
#define XB_SPIN(cond, bar) do { unsigned _sp = 0; while (cond) { __builtin_amdgcn_s_sleep(1); \
    if ((++_sp & 255u) == 0u) { if (xb_ld(&(bar)[XB_TMO])) break; if (_sp > XB_SPIN_CAP) { atomicAdd(&(bar)[XB_TMO], 1u); break; } } } } while (0)

struct XcdBarrier {
    unsigned* bar; unsigned x;
    volatile LAS unsigned* st;
};

__device__ __forceinline__ XcdBarrier xcd_barrier_post(unsigned* bar, volatile LAS unsigned* st) {
    XcdBarrier b; b.bar = bar; b.x = xb_xcc_id(); b.st = st;
    if (threadIdx.x == 0) (void)xb_add(&bar[XB_XCNT(b.x)], 1u);
    return b;
}
__device__ __forceinline__ void xcd_barrier_complete(unsigned* bar, unsigned x, unsigned& nloc, unsigned& nx) {
    const unsigned G = gridDim.x * gridDim.y * gridDim.z;
    unsigned sum, cnt, mine, sp = 0u;
    for (;;) {
        sum = 0u; cnt = 0u; mine = 0u;
#pragma unroll
        for (unsigned j = 0; j < 16; ++j) { const unsigned c = xb_ld(&bar[XB_XCNT(j)]); sum += c; cnt += (c > 0u) ? 1u : 0u; mine = (j == x) ? c : mine; }
        if (sum == G) break;
        __builtin_amdgcn_s_sleep(1);
        if ((++sp & 255u) == 0u) { if (xb_ld(&bar[XB_TMO])) break; if (sp > XB_SPIN_CAP) { atomicAdd(&bar[XB_TMO], 1u); break; } }
    }
    nloc = mine > 0u ? mine : 1u; nx = cnt > 0u ? cnt : 1u;
}

__device__ __forceinline__ void xcd_barrier(const XcdBarrier& b) {
    asm volatile("s_waitcnt vmcnt(0)" ::: "memory");
    __syncthreads();
    if (threadIdx.x == 0) {
        unsigned* bar = b.bar;
        __builtin_amdgcn_s_waitcnt(0);
        unsigned nloc = b.st[0], nx = b.st[1];
        if (nloc == 0u) { xcd_barrier_complete(bar, b.x, nloc, nx); b.st[0] = nloc; b.st[1] = nx; }
        const unsigned old = xb_add(&bar[XB_XSUB(b.x)], 1u);
        const unsigned gen = old / nloc;
        if (old + 1u == (gen + 1u) * nloc) {
            __builtin_amdgcn_fence(__ATOMIC_RELEASE, "agent");
            asm volatile("s_waitcnt vmcnt(0)" ::: "memory");
            const unsigned og = xb_add(&bar[XB_TOP], 1u);
            const unsigned tg = og / nx;
            if (og + 1u == (tg + 1u) * nx) xb_add(&bar[XB_TOPGEN], 1u);
            else XB_SPIN(xb_ld(&bar[XB_TOPGEN]) == tg, bar);
            __builtin_amdgcn_fence(__ATOMIC_ACQUIRE, "agent");
            xb_add(&bar[XB_XGEN(b.x)], 1u);
            asm volatile("s_waitcnt vmcnt(0)" ::: "memory");
        } else {
            XB_SPIN(xb_ld(&bar[XB_XGEN(b.x)]) == gen, bar);
            __builtin_amdgcn_fence(__ATOMIC_ACQUIRE, "agent");
            asm volatile("s_waitcnt vmcnt(0)" ::: "memory");
        }
    }
    __syncthreads();
}

constexpr int NPHASE = 2 + 6 * DEPTH + 1;
__global__ void __launch_bounds__(NTHREADS, 2) fwd(Args a) {
    extern __shared__ __attribute__((aligned(16))) unsigned char lds_raw[];
    LAS unsigned char* lds = (LAS unsigned char*)lds_raw;
    const int G = gridDim.x, bx = blockIdx.x;
    volatile LAS unsigned* bst = (volatile LAS unsigned*)(lds + LDS_BYTES - 16);
    if (threadIdx.x < 2) bst[threadIdx.x] = 0u;
    __syncthreads();
    XcdBarrier xbar = xcd_barrier_post((unsigned*)(a.ws + WS_BAR), bst);
    for (int ph = a.lo; ph < a.hi; ++ph) {
        if (ph > a.lo) xcd_barrier(xbar);
        if (ph == 0) { phase_p0a(a, lds); continue; }
        if (ph == 1) { phase_p0b(a); continue; }
        if (ph == NPHASE - 1) { phase_final(a); continue; }
        const int l = (ph - 2) / 6, sp = (ph - 2) % 6;
        const bool lastl = (l == DEPTH - 1);
        unsigned char* wl = a.ws + WS_WT + (size_t)l * WT_LAYER;
        const float* mod = (const float*)(a.ws + WS_MOD) + (size_t)l * 5 * NMODC;
        float* ss = (float*)(a.ws + WS_SS);
        float* slab = (float*)(a.ws + WS_SLAB);
        if (sp == 0) {
            pg8::Gemm g{(const bf16_t*)(a.ws + WS_XG), (const bf16_t*)(wl + WT_IN), DM, 64, DM, slab, (size_t)256 * 64 * 2, (size_t)256 * DM * 2};
            pg8::Order S; S.init(lastl ? 64 : 68, 7, G, bx, lastl ? 4 : 0, 64, DM / 64, 0);
            pg8::EpiLin<0> E{(bf16_t*)(a.ws + WS_PX), DIN, ss, (const float*)(a.ws + WS_SWIN) + (size_t)l * 5 * DIN, DIN};
            pg8::gemm_phase<pg8::EpiLin<0>>(lds, g, S, E);
        } else if (sp == 1 || sp == 2) {
            const int nT = lastl ? 128 : NTILE;
            const int total = sp == 1 ? 256 : 3 * nT + (nT - 120);
            unsigned* qcnt = (unsigned*)(a.ws + WS_BAR) + 3520 + 8 * (l * 2 + (sp - 1));
            volatile LAS int* qw = (volatile LAS int*)(lds + LDS_BYTES - 8);
            int u = bx;
            while (u < total) {
                if (sp == 1) { if (u < NTILE) lru_unit<0>(a, lds, l, u < 128 ? 16 * (u & 7) + (u >> 3) : u); else conv_unit(a, lds, l, u - NTILE); }
                else {
                    if (u < nT) lru_unit<1>(a, lds, l, u < 128 ? 16 * (u & 7) + (u >> 3) : u);
                    else if (u < 2 * nT - 120) conv_unit(a, lds, l, 120 + (u - nT));
                    else if (u < 3 * nT - 120) sgu_unit(a, lds, l, u - (2 * nT - 120));
                    else pool_unit(a, lds, l, u - (3 * nT - 120));
                }
                if (threadIdx.x == 0) qw[0] = G + (int)__hip_atomic_fetch_add(qcnt, 1u, __ATOMIC_RELAXED, __HIP_MEMORY_SCOPE_AGENT);
                __syncthreads();
                u = qw[0];
                __syncthreads();
            }
        } else if (sp == 3) {
            const float* tab = (const float*)(a.ws + WS_TAB) + (size_t)(2 * l) * 15 * DM;
            pg8::Gemm g{(const bf16_t*)(a.ws + WS_MIX), (const bf16_t*)(wl + WT_OUT), DM, 64, DM, slab, (size_t)256 * 64 * 2, (size_t)256 * DM * 2};
            pg8::Order S; S.init(64, 4, G, bx, lastl ? 0 : 16 * 4, 64, DM / 64, 4);
            pg8::EpiRes E{(bf16_t*)(a.ws + WS_XG), ss, tab};
            pg8::gemm_phase<pg8::EpiRes>(lds, g, S, E);
            if (!lastl) { xcd_barrier(xbar); finish_ctx<4>(a, slab, tab); }
        } else if (sp == 4) {
            pg8::Gemm g{(const bf16_t*)(a.ws + WS_XG), (const bf16_t*)(wl + WT_1), DM, 64, DM, slab, (size_t)256 * 64 * 2, (size_t)256 * DM * 2};
            pg8::Order S; S.init(lastl ? 64 : 68, 16, G, bx, 0, 0, DM / 64, 0);
            pg8::EpiLin<1, true> E{(bf16_t*)(a.ws + WS_H), DFF, ss, (const float*)(a.ws + WS_SW1) + (size_t)l * 5 * DFF, DFF};
            pg8::gemm_phase<pg8::EpiLin<1, true>>(lds, g, S, E);
            if (!lastl) {
                const int nwg = 68 * 16, extra = nwg % G, first = extra ? extra : 0;
                if (bx >= first) transpose_layers(a, lds, l + 1, l + 2, bx - first, G - first);
            }
        } else {
            const float* tab = (const float*)(a.ws + WS_TAB) + (size_t)(2 * l + 1) * 15 * DM;
            pg8::Gemm g{(const bf16_t*)(a.ws + WS_H), (const bf16_t*)(wl + WT_2), DFF, 64, HP, slab, (size_t)256 * 64 * 2, (size_t)256 * DFF * 2};
            pg8::Order S; S.init(64, 4, G, bx, lastl ? 0 : 16 * 8, 64, DFF / 64, 8);
            pg8::EpiRes E{(bf16_t*)(a.ws + WS_XG), ss, tab};
            pg8::gemm_phase<pg8::EpiRes>(lds, g, S, E);
            if (!lastl) {
                const int first = (G == 256) ? 128 : 0;
                if (bx >= first) sw_layers(a, l + 1, l + 2, bx - first, G - first);
                xcd_barrier(xbar); finish_ctx<8>(a, slab, tab);
            }
        }
    }
}

extern "C" void kernel_launch(void* const* d_in, const int* in_sizes, int n_in, void* d_out, int out_size, void* d_ws, size_t ws_size, hipStream_t stream) {
    static int grid = 0;
    if (grid == 0) {
        if (n_in != 30 || ws_size < WS_END) { fprintf(stderr, "kernel_launch: need 30 inputs and >= %zu bytes of workspace (got %d, %zu)\n", (size_t)WS_END, n_in, ws_size); grid = -1; return; }
        int dev = 0, cus = 0, per_cu = 0;
        hipGetDevice(&dev);
        hipDeviceGetAttribute(&cus, hipDeviceAttributeMultiprocessorCount, dev);
        hipFuncSetAttribute((const void*)fwd, hipFuncAttributeMaxDynamicSharedMemorySize, LDS_BYTES);
        hipOccupancyMaxActiveBlocksPerMultiprocessor(&per_cu, (const void*)fwd, NTHREADS, LDS_BYTES);
        (void)hipGetLastError();
        if (per_cu < 1) { fprintf(stderr, "kernel_launch: occupancy query says %d blocks per CU; nothing launched\n", per_cu); grid = -1; return; }
        grid = cus * (per_cu < 1 ? per_cu : 1);
    }
    if (grid < 0) return;
    Args a{};
    for (int i = 0; i < 30; ++i) a.in[i] = (const float*)d_in[i];
    a.out = (float*)d_out; a.ws = (unsigned char*)d_ws;
    a.lo = 0; a.hi = NPHASE;
    (void)hipMemsetAsync((char*)d_ws + WS_BAR, 0, 16384, stream);
    void* args[] = {&a};
    hipError_t e = hipLaunchCooperativeKernel((const void*)fwd, dim3(grid), dim3(NTHREADS), args, LDS_BYTES, stream);
    if (e != hipSuccess) fprintf(stderr, "cooperative launch failed: %s (grid %d)\n", hipGetErrorString(e), grid);
}
```
